# Optimizing an MI355X kernel written in HIP

```python
import math
import jax
import jax.numpy as jnp
from jax import lax
import numpy as np

D_MODEL = 2048
BATCH = 1
SEQ = 16384
DEPTH = 4

CHUNK = 64
N_MIXERS = 2
N_A = (DEPTH + N_MIXERS - 1) // N_MIXERS
N_B = DEPTH // N_MIXERS

A_HEADS = 16
A_HEAD_DIM = D_MODEL // A_HEADS
A_LEFT_CHUNKS = 8
A_PAD = A_LEFT_CHUNKS * CHUNK
A_BAND = (A_LEFT_CHUNKS + 1) * CHUNK
A_REL_CLIP = 128

B_HEADS = 8
B_QK_DIM = D_MODEL // (2 * B_HEADS)
B_V_DIM = 2 * B_QK_DIM
Q_BLOCK = 128

T5_BUCKETS = 32
T5_MAX_DIST = 128

D_FF = 4 * D_MODEL

EPS = 1e-6
NEG_INF = -1e30

kernel_name = "hybrid_chunkband_diffattn_sqrelu_trunk"


def rmsnorm(x, g):
    xf = x.astype(jnp.float32)
    y = xf * lax.rsqrt(jnp.mean(xf * xf, axis=-1, keepdims=True) + EPS)
    return (y * g.astype(jnp.float32)).astype(x.dtype)


def lambda_init_fn(layer):
    return 0.8 - 0.6 * math.exp(-0.3 * layer)


def t5_bucket(rel):
    half = T5_BUCKETS // 2
    max_exact = half // 2
    ret = (rel > 0).astype(jnp.int32) * half
    n = jnp.abs(rel)
    nf = jnp.maximum(n, 1).astype(jnp.float32)
    large = max_exact + (jnp.log(nf / max_exact) / math.log(T5_MAX_DIST / max_exact)
                         * (half - max_exact)).astype(jnp.int32)
    large = jnp.minimum(large, half - 1)
    return ret + jnp.where(n < max_exact, n, large)


def chunk_band_attention(h, w_qkv, w_o, rel_bias):
    b, s, _ = h.shape
    q, k, v = jnp.split(h @ w_qkv, 3, axis=-1)
    q = q.reshape(b, s, A_HEADS, A_HEAD_DIM)
    k = jnp.pad(k.reshape(b, s, A_HEADS, A_HEAD_DIM), ((0, 0), (A_PAD, 0), (0, 0), (0, 0)))
    v = jnp.pad(v.reshape(b, s, A_HEADS, A_HEAD_DIM), ((0, 0), (A_PAD, 0), (0, 0), (0, 0)))
    rel = (jnp.arange(A_BAND) - A_PAD)[None, :] - jnp.arange(CHUNK)[:, None]
    idx = jnp.clip(rel, -A_REL_CLIP, A_REL_CLIP) + A_REL_CLIP
    bias = jnp.transpose(rel_bias[idx], (2, 0, 1)).astype(jnp.float32)
    scale = A_HEAD_DIM ** -0.5
    band_offs = jnp.arange(A_BAND) - A_PAD

    def one_chunk(c):
        start = c * CHUNK
        qc = lax.dynamic_slice_in_dim(q, start, CHUNK, axis=1)
        kc = lax.dynamic_slice_in_dim(k, start, A_BAND, axis=1)
        vc = lax.dynamic_slice_in_dim(v, start, A_BAND, axis=1)
        logits = jnp.einsum('bqhd,bkhd->bhqk', qc, kc).astype(jnp.float32) * scale + bias
        valid = (start + band_offs) >= 0
        logits = jnp.where(valid[None, None, None, :], logits, NEG_INF)
        p = jax.nn.softmax(logits, axis=-1).astype(vc.dtype)
        return jnp.einsum('bhqk,bkhd->bqhd', p, vc)

    o = lax.map(one_chunk, jnp.arange(s // CHUNK))
    o = jnp.moveaxis(o, 0, 1).reshape(b, s, D_MODEL)
    return o @ w_o


def diff_attention(h, w_qkv, w_o, lam, subln_g, t5_table, lambda_init):
    b, s, _ = h.shape
    q, k, v = jnp.split(h @ w_qkv, 3, axis=-1)
    q = q.reshape(b, s, B_HEADS, 2, B_QK_DIM)
    k = k.reshape(b, s, B_HEADS, 2, B_QK_DIM)
    v = v.reshape(b, s, B_HEADS, B_V_DIM)
    lf = lam.astype(jnp.float32)
    lam_full = jnp.exp(jnp.sum(lf[0] * lf[1])) - jnp.exp(jnp.sum(lf[2] * lf[3])) + lambda_init
    scale = B_QK_DIM ** -0.5
    k_pos = jnp.arange(s)
    k_chunk = k_pos // CHUNK

    def one_block(blk):
        start = blk * Q_BLOCK
        qb = lax.dynamic_slice_in_dim(q, start, Q_BLOCK, axis=1)
        logits = jnp.einsum('bqhmd,bkhmd->bmhqk', qb, k).astype(jnp.float32) * scale
        q_pos = start + jnp.arange(Q_BLOCK)
        rel = k_pos[None, :] - q_pos[:, None]
        bias = jnp.transpose(t5_table[t5_bucket(rel)], (2, 0, 1)).astype(jnp.float32)
        allowed = k_chunk[None, :] <= (q_pos // CHUNK)[:, None]
        logits = jnp.where(allowed, logits + bias, NEG_INF)
        p = jax.nn.softmax(logits, axis=-1)
        attn = p[:, 0] - lam_full * p[:, 1]
        return jnp.einsum('bhqk,bkhe->bqhe', attn.astype(v.dtype), v)

    o = lax.map(one_block, jnp.arange(s // Q_BLOCK))
    o = jnp.moveaxis(o, 0, 1).reshape(b, s, B_HEADS, B_V_DIM)
    o = rmsnorm(o, subln_g) * (1.0 - lambda_init)
    return o.reshape(b, s, D_MODEL) @ w_o


def squared_relu_mlp(h, w_up, w_down):
    return jnp.square(jax.nn.relu(h @ w_up)) @ w_down


def setup_inputs(seed: int = 0) -> dict:
    key = jax.random.key(seed)
    ks = jax.random.split(key, 12)
    f32 = jnp.float32
    x = jax.random.normal(ks[0], (BATCH, SEQ, D_MODEL), f32)
    norm_g = 1.0 + 0.05 * jax.random.normal(ks[1], (DEPTH, 4, D_MODEL), f32)
    a_w_qkv = jax.random.normal(ks[2], (N_A, D_MODEL, 3 * D_MODEL), f32) * D_MODEL ** -0.5
    a_w_o = jax.random.normal(ks[3], (N_A, D_MODEL, D_MODEL), f32) * D_MODEL ** -0.5
    a_rel_bias = 0.5 * jax.random.normal(ks[4], (N_A, 2 * A_REL_CLIP + 1, A_HEADS), f32)
    b_w_qkv = jax.random.normal(ks[5], (N_B, D_MODEL, 3 * D_MODEL), f32) * D_MODEL ** -0.5
    b_w_o = jax.random.normal(ks[6], (N_B, D_MODEL, D_MODEL), f32) * D_MODEL ** -0.5
    b_lambda = 0.1 * jax.random.normal(ks[7], (N_B, 4, B_QK_DIM), f32)
    b_subln_g = 1.0 + 0.05 * jax.random.normal(ks[8], (N_B, B_V_DIM), f32)
    t5_bias = 0.5 * jax.random.normal(ks[9], (T5_BUCKETS, B_HEADS), f32)
    w_up = jax.random.normal(ks[10], (DEPTH, D_MODEL, D_FF), f32) * D_MODEL ** -0.5
    w_down = jax.random.normal(ks[11], (DEPTH, D_FF, D_MODEL), f32) * D_FF ** -0.5
    return {"x": x, "norm_g": norm_g, "a_w_qkv": a_w_qkv, "a_w_o": a_w_o,
            "a_rel_bias": a_rel_bias, "b_w_qkv": b_w_qkv, "b_w_o": b_w_o,
            "b_lambda": b_lambda, "b_subln_g": b_subln_g, "t5_bias": t5_bias,
            "w_up": w_up, "w_down": w_down}


def reference(x, norm_g, a_w_qkv, a_w_o, a_rel_bias, b_w_qkv, b_w_o, b_lambda,
              b_subln_g, t5_bias, w_up, w_down):
    h = x
    for layer in range(DEPTH):
        g = norm_g[layer]
        i = layer // N_MIXERS
        y = rmsnorm(h, g[0])
        if layer % N_MIXERS == 0:
            y = chunk_band_attention(y, a_w_qkv[i], a_w_o[i], a_rel_bias[i])
        else:
            y = diff_attention(y, b_w_qkv[i], b_w_o[i], b_lambda[i], b_subln_g[i],
                               t5_bias, lambda_init_fn(layer))
        h = h + rmsnorm(y, g[1])
        y = rmsnorm(h, g[2])
        h = h + rmsnorm(squared_relu_mlp(y, w_up[layer], w_down[layer]), g[3])
    return h
```

```cpp
#include <hip/hip_runtime.h>
#include <hip/hip_cooperative_groups.h>
#include <cstdio>
#include <cstdint>
#include <cmath>
namespace cg = cooperative_groups;
#ifndef MK_ONE_LAUNCH
#define MK_ONE_LAUNCH 1
#endif
namespace pg8 {
#define PG8_LAS __attribute__((address_space(3)))
typedef unsigned short bf16_t;
typedef short bf16x8 __attribute__((ext_vector_type(8)));
typedef float f32x4 __attribute__((ext_vector_type(4)));
typedef unsigned u32x4 __attribute__((ext_vector_type(4)));
constexpr int BM = 256, BK = 64, HALF = 128, HTB = HALF * BK * 2  , STAGE_BYTES = 8 * HTB, NXCD = 8, WGM = 8;

__host__ __device__ __forceinline__ int lds_byte(int r, int c) { const int st = (r >> 4) * 2 + (c >> 5), rr = r & 15, cc = c & 31, ob = rr * 64 + cc * 2; return st * 1024 + (ob ^ (((ob >> 9) & 1) << 5)); }
__host__ __device__ __forceinline__ void stage_rc(int b, int& R, int& C) { const int st = b / 1024, sb = b % 1024, swz = sb ^ (((sb >> 9) & 1) << 5); R = (st >> 1) * 16 + swz / 64; C = (st & 1) * 32 + (swz % 64) / 2; }
__host__ __device__ __forceinline__ int perm32(int rho) { const int n = rho >> 4, i = rho & 15; return 8 * (i >> 2) + 4 * n + (i & 3); }

struct Unit { int pm, pn; };
struct Gemm { const bf16_t* A; const bf16_t* Bt; int M, N, K; };

struct StaticOrder {
    int nM, nN, nwg, G, c;
    __host__ __device__ void init(int M, int N, int G_, int c_) { nM = M / BM; nN = N / BM; nwg = nM * nN; G = G_; c = c_; }
    __host__ __device__ bool next(int i, Unit& u) const {
        const long L = (long)i * G + c; if (L >= nwg) return false;
        int wgid = (int)L; { const int q = nwg / NXCD, r = nwg % NXCD, xcd = wgid % NXCD, off = wgid / NXCD; wgid = (xcd < r ? xcd * (q + 1) : r * (q + 1) + (xcd - r) * q) + off; }
        const int nig = WGM * nN, gid = wgid / nig, fm = gid * WGM, gsz = (nM - fm) < WGM ? (nM - fm) : WGM;
        u.pm = fm + ((wgid % nig) % gsz); u.pn = (wgid % nig) / gsz; return true;
    }
    __device__ __forceinline__ void a_ready(const Unit&) const {}
    __device__ __forceinline__ void done(const Unit&) const {}
};

__device__ __forceinline__ unsigned cvt_pk_bf16(float lo, float hi) { unsigned r; asm volatile("v_cvt_pk_bf16_f32 %0, %1, %2" : "=v"(r) : "v"(lo), "v"(hi)); return r; }
typedef float f32x2 __attribute__((ext_vector_type(2)));
template <int ACT  > struct EpiBf16 {
    static constexpr bool PERM = true, AFTER_DRAIN = false;
    bf16_t* O; int ldc; int scale_cols; float scale0; const float* rs; int rsmode;
    __device__ __forceinline__ void operator()(const f32x4 (&acc)[2][2][4][2], const Unit& u, int wr, int wc, int fr, int fq) const {
        const int row0 = u.pm * BM + wr * 64 + fr; const int colt = u.pn * BM;
        const float sc = (colt < scale_cols) ? scale0 : 1.f;
        const int col0 = colt + wc * 32 + 8 * fq;
        f32x4 cs[2][2];
#pragma unroll
        for (int bj = 0; bj < 2; ++bj) { cs[bj][0] = (f32x4){1.f, 1.f, 1.f, 1.f}; cs[bj][1] = cs[bj][0]; if (rsmode == 2) { cs[bj][0] = *(const f32x4*)(rs + col0 + bj * HALF); cs[bj][1] = *(const f32x4*)(rs + col0 + bj * HALF + 4); } }
#pragma unroll
        for (int ai = 0; ai < 2; ++ai)
#pragma unroll
            for (int m = 0; m < 4; ++m) { bf16_t* rowp = O + (size_t)(row0 + ai * HALF + m * 16) * ldc + col0;
                float rsc = sc; if (rsmode == 1) { const float r_ = rs[row0 + ai * HALF + m * 16]; rsc = sc * (ACT == 2 ? r_ * r_ : r_); }
#pragma unroll
                for (int bj = 0; bj < 2; ++bj) { f32x4 v0 = acc[ai][bj][m][0], v1 = acc[ai][bj][m][1];
                    if (ACT == 2) {
#pragma unroll
                        for (int e = 0; e < 4; ++e) { const float a0 = fmaxf(v0[e], 0.f), a1 = fmaxf(v1[e], 0.f); v0[e] = a0 * a0; v1[e] = a1 * a1; } }
                    v0 = v0 * cs[bj][0] * rsc; v1 = v1 * cs[bj][1] * rsc; u32x4 w; w.x = cvt_pk_bf16(v0[0], v0[1]); w.y = cvt_pk_bf16(v0[2], v0[3]); w.z = cvt_pk_bf16(v1[0], v1[1]); w.w = cvt_pk_bf16(v1[2], v1[3]);
                    *(u32x4*)(rowp + bj * HALF) = w; } }
    }
};
template <class Epi, class Sched, bool ALIGN_EPI = false, bool SP2 = false>
__device__ __forceinline__ void gemm_phase(PG8_LAS unsigned char* lds, const Gemm g, const Sched& S, const Epi& E) {
    int tid_ = threadIdx.x; asm volatile("" : "+v"(tid_));
    const int tid = tid_, wid = __builtin_amdgcn_readfirstlane(tid >> 6), lane = tid & 63, wr = wid >> 2, wc = wid & 3, fr = lane & 15, fq = lane >> 4;
    const int K = g.K, nt = K / BK;
    unsigned voffA[2], voffB[2];
#pragma unroll
    for (int i = 0; i < 2; ++i) { int R, C; stage_rc(tid * 16 + i * 8192, R, C); const int Rb = Epi::PERM ? ((R & ~31) + perm32(R & 31)) : R;
        voffA[i] = (unsigned)(R * K + C) * 2u; voffB[i] = (unsigned)(Rb * K + C) * 2u; }
    const size_t kstep = (size_t)(BK * 2);
    const size_t hstep = (size_t)HALF * K * 2;
    const size_t tstep = 2 * hstep;
    const unsigned ldsw = (unsigned)wid * 1024u;
    const int aoff = lds_byte(wr * 64 + fr, fq * 8), boff = lds_byte(wc * 32 + fr, fq * 8);
#define PG8_SA(b, h) (((b) * 2 + (h)) * HTB)
#define PG8_SB(b, h) ((4 + (b) * 2 + (h)) * HTB)
#define PG8_STAGE(bufoff, gbase, voff) do { _Pragma("unroll") for (int _i = 0; _i < 2; ++_i) \
        __builtin_amdgcn_global_load_lds((const unsigned*)((const char*)(gbase) + (voff)[_i]), (PG8_LAS unsigned*)(lds + (bufoff) + ldsw + _i * 8192), 16, 0, 0); } while (0)
#define PG8_LDA(dst, b, h) do { _Pragma("unroll") for (int m = 0; m < 4; ++m) _Pragma("unroll") for (int k = 0; k < 2; ++k) dst[m][k] = *(const PG8_LAS bf16x8*)(lds + PG8_SA(b, h) + aoff + m * 2048 + k * 1024); } while (0)
#define PG8_LDB(dst, b, h) do { _Pragma("unroll") for (int n = 0; n < 2; ++n) _Pragma("unroll") for (int k = 0; k < 2; ++k) dst[n][k] = *(const PG8_LAS bf16x8*)(lds + PG8_SB(b, h) + boff + n * 2048 + k * 1024); } while (0)
#define PG8_MMA(ai, bj, At, Bt) do { __builtin_amdgcn_s_setprio(1); _Pragma("unroll") for (int m = 0; m < 4; ++m) _Pragma("unroll") for (int n = 0; n < 2; ++n) _Pragma("unroll") for (int k = 0; k < 2; ++k) \
        acc[ai][bj][m][n] = __builtin_amdgcn_mfma_f32_16x16x32_bf16(Bt[n][k], At[m][k], acc[ai][bj][m][n], 0, 0, 0); __builtin_amdgcn_s_setprio(0); } while (0)
#define PG8_WAIT_V(n) asm volatile("s_waitcnt vmcnt(" #n ")" ::: "memory")
#define PG8_WAIT_L(n) asm volatile("s_waitcnt lgkmcnt(" #n ")" ::: "memory")
#define PG8_BAR __builtin_amdgcn_s_barrier()
#define PG8_SCHED __builtin_amdgcn_sched_barrier(0)
    Unit cur, nxt; int ui = 0;
    if (!S.next(0, cur)) return;
    f32x4 acc[2][2][4][2];
#pragma unroll
    for (int a = 0; a < 2; ++a)
#pragma unroll
        for (int b = 0; b < 2; ++b)
#pragma unroll
            for (int m = 0; m < 4; ++m)
#pragma unroll
                for (int n = 0; n < 2; ++n) acc[a][b][m][n] = (f32x4){0.f, 0.f, 0.f, 0.f};
    bf16x8 At[4][2], B0[2][2], B1[2][2];
    const char* cA = (const char*)g.A + (size_t)cur.pm * tstep; const char* cB = (const char*)g.Bt + (size_t)cur.pn * tstep;
    S.a_ready(cur);
    if constexpr (SP2) {
        PG8_STAGE(PG8_SB(0, 0), cB, voffB); PG8_STAGE(PG8_SB(0, 1), cB + hstep, voffB); PG8_STAGE(PG8_SA(0, 0), cA, voffA); PG8_STAGE(PG8_SA(0, 1), cA + hstep, voffA);
        if (wr == 1) PG8_BAR;
        PG8_WAIT_V(2); PG8_BAR;
        PG8_STAGE(PG8_SB(1, 0), cB + kstep, voffB); PG8_STAGE(PG8_SB(1, 1), cB + hstep + kstep, voffB);
        PG8_WAIT_V(4); PG8_BAR;
    } else {
        PG8_STAGE(PG8_SB(0, 0), cB, voffB); PG8_STAGE(PG8_SA(0, 0), cA, voffA); PG8_STAGE(PG8_SB(0, 1), cB + hstep, voffB); PG8_STAGE(PG8_SA(0, 1), cA + hstep, voffA);
        if (wr == 1) PG8_BAR;
        PG8_WAIT_V(4); PG8_BAR;
        PG8_STAGE(PG8_SB(1, 0), cB + kstep, voffB); PG8_STAGE(PG8_SA(1, 0), cA + kstep, voffA); PG8_STAGE(PG8_SB(1, 1), cB + hstep + kstep, voffB);
        PG8_WAIT_V(6); PG8_BAR;
    }
    for (;;) {
        const bool has_next = S.next(ui + 1, nxt);
        const char* nA = has_next ? (const char*)g.A + (size_t)nxt.pm * tstep : cA; const char* nB = has_next ? (const char*)g.Bt + (size_t)nxt.pn * tstep : cB;
        for (int t = 0; t < nt; t += 2) {
            const bool last = (t == nt - 2);
            const char* a1 = cA + (size_t)(t + 1) * kstep;
            const char* a2 = last ? nA : cA + (size_t)(t + 2) * kstep; const char* b2 = last ? nB : cB + (size_t)(t + 2) * kstep;
            const char* a3 = a2 + kstep; const char* b3 = b2 + kstep;
            if (last && has_next) S.a_ready(nxt);
            if constexpr (SP2) {
            PG8_LDB(B0, 0, 0); PG8_LDB(B1, 0, 1); PG8_SCHED; PG8_LDA(At, 0, 0); PG8_STAGE(PG8_SA(1, 0), a1, voffA); PG8_STAGE(PG8_SA(1, 1), a1 + hstep, voffA);
            PG8_WAIT_V(8); PG8_WAIT_L(0); PG8_BAR; PG8_MMA(0, 0, At, B0); PG8_MMA(0, 1, At, B1); PG8_BAR; PG8_SCHED;
            PG8_LDA(At, 0, 1); PG8_STAGE(PG8_SB(0, 0), b2, voffB); PG8_STAGE(PG8_SB(0, 1), b2 + hstep, voffB);
            PG8_WAIT_V(6); PG8_WAIT_L(0); PG8_BAR; PG8_MMA(1, 0, At, B0); PG8_MMA(1, 1, At, B1); PG8_BAR; PG8_SCHED;
            PG8_LDB(B0, 1, 0); PG8_LDB(B1, 1, 1); PG8_SCHED; PG8_LDA(At, 1, 0); PG8_STAGE(PG8_SA(0, 0), a2, voffA); PG8_STAGE(PG8_SA(0, 1), a2 + hstep, voffA);
            PG8_WAIT_V(8); PG8_WAIT_L(0); PG8_BAR; PG8_MMA(0, 0, At, B0); PG8_MMA(0, 1, At, B1); PG8_BAR; PG8_SCHED;
            PG8_LDA(At, 1, 1); PG8_STAGE(PG8_SB(1, 0), b3, voffB); PG8_STAGE(PG8_SB(1, 1), b3 + hstep, voffB); (void)a3;
            PG8_WAIT_V(6); PG8_WAIT_L(0); PG8_BAR; PG8_MMA(1, 0, At, B0); PG8_MMA(1, 1, At, B1); PG8_BAR; PG8_SCHED;
            } else {
            PG8_LDB(B0, 0, 0); PG8_SCHED; PG8_LDA(At, 0, 0); PG8_STAGE(PG8_SA(1, 1), a1 + hstep, voffA);
            PG8_WAIT_L(8); PG8_BAR; PG8_WAIT_L(0); PG8_MMA(0, 0, At, B0); PG8_BAR; PG8_SCHED;
            PG8_LDB(B1, 0, 1); PG8_STAGE(PG8_SB(0, 0), b2, voffB);
            PG8_BAR; PG8_WAIT_L(0); PG8_MMA(0, 1, At, B1); PG8_BAR;
            PG8_LDA(At, 0, 1); PG8_STAGE(PG8_SA(0, 0), a2, voffA);
            PG8_BAR; PG8_WAIT_L(0); PG8_MMA(1, 0, At, B0); PG8_BAR; PG8_SCHED;
            PG8_STAGE(PG8_SB(0, 1), b2 + hstep, voffB);
            PG8_WAIT_V(6); PG8_BAR; PG8_MMA(1, 1, At, B1); PG8_BAR;
            PG8_LDB(B0, 1, 0); PG8_SCHED; PG8_LDA(At, 1, 0); PG8_STAGE(PG8_SA(0, 1), a2 + hstep, voffA);
            PG8_WAIT_L(8); PG8_BAR; PG8_WAIT_L(0); PG8_MMA(0, 0, At, B0); PG8_BAR; PG8_SCHED;
            PG8_LDB(B1, 1, 1); PG8_STAGE(PG8_SB(1, 0), b3, voffB);
            PG8_BAR; PG8_WAIT_L(0); PG8_MMA(0, 1, At, B1); PG8_BAR;
            PG8_LDA(At, 1, 1); PG8_STAGE(PG8_SA(1, 0), a3, voffA);
            PG8_BAR; PG8_WAIT_L(0); PG8_MMA(1, 0, At, B0); PG8_BAR; PG8_SCHED;
            PG8_STAGE(PG8_SB(1, 1), b3 + hstep, voffB);
            PG8_WAIT_V(6); PG8_BAR; PG8_MMA(1, 1, At, B1); PG8_BAR;
            }
        }
        if constexpr (ALIGN_EPI) { if (wr == 0) PG8_BAR; }
        if constexpr (!Epi::AFTER_DRAIN) { E(acc, cur, wr, wc, fr, fq); S.done(cur); }
        if (!has_next) break;
#pragma unroll
        for (int a = 0; a < 2; ++a)
#pragma unroll
            for (int b = 0; b < 2; ++b)
#pragma unroll
                for (int m = 0; m < 4; ++m)
#pragma unroll
                    for (int n = 0; n < 2; ++n) acc[a][b][m][n] = (f32x4){0.f, 0.f, 0.f, 0.f};
        cur = nxt; cA = nA; cB = nB; ++ui;
        if constexpr (ALIGN_EPI) { if (wr == 1) PG8_BAR; }
    }
    PG8_WAIT_V(0);
    if constexpr (!ALIGN_EPI) { if (wr == 0) PG8_BAR; }
    PG8_BAR;
    if constexpr (Epi::AFTER_DRAIN) { E.fused(acc, cur, wr, wc, fr, fq, lds, wid, lane); S.done(cur); }
#undef PG8_SA
#undef PG8_SB
#undef PG8_STAGE
#undef PG8_LDA
#undef PG8_LDB
#undef PG8_MMA
#undef PG8_WAIT_V
#undef PG8_WAIT_L
#undef PG8_BAR
#undef PG8_SCHED
}
}

constexpr int SEQ = 16384, DM = 2048, DFF = 8192, DEPTH = 4;
constexpr int QKLD = 4096;
constexpr int VTLD = SEQ;
constexpr float RMS_EPS = 1e-6f;
constexpr float LOG2E = 1.4426950408889634f;
constexpr int ONE_LAUNCH = MK_ONE_LAUNCH;
#ifndef REP_ATTA
#define REP_ATTA 1
#endif
#ifndef REP_ATTB
#define REP_ATTB 1
#endif
#ifndef REP_DMA
#define REP_DMA 1
#endif
#ifndef REP_UP
#define REP_UP 1
#endif
#ifndef REP_P0
#define REP_P0 1
#endif

constexpr size_t MiB = 1u << 20;
constexpr size_t WS_BAR = 0, BAR_BYTES = 16384;
constexpr size_t WS_TAB = 1 * MiB;
constexpr size_t WS_NORMG = 2 * MiB, WS_BLAM = 2 * MiB + 256 * 1024, WS_BSUB = 2 * MiB + 384 * 1024;
constexpr size_t WS_RS = 3 * MiB;
constexpr size_t WS_W = 16 * MiB, W_LAYER = 96 * MiB;
constexpr size_t W_QKV = 0, W_O = 24 * MiB, W_UP = 32 * MiB, W_DOWN = 64 * MiB;
constexpr size_t WS_XN = 400 * MiB;
constexpr size_t WS_QK = 464 * MiB;
constexpr size_t WS_VT = 592 * MiB;
constexpr size_t WS_O = 656 * MiB;
constexpr size_t WS_U = 464 * MiB;
constexpr size_t WS_Y = 720 * MiB;
constexpr size_t WS_HB = 784 * MiB;
constexpr size_t WS_END = 848 * MiB;

constexpr int LDS_RING = 131072, TAB_OFF = 131072, XBST_OFF = 131072 + 1024, LDS_BYTES = 131072 + 1024 + 16;

#define LAS __attribute__((address_space(3)))
typedef unsigned short bf16;
typedef unsigned v4u __attribute__((ext_vector_type(4)));
typedef unsigned v2u __attribute__((ext_vector_type(2)));
typedef float f32x4 __attribute__((ext_vector_type(4)));
typedef short bf16x8 __attribute__((ext_vector_type(8)));
#define LDS_WAIT() asm volatile("s_waitcnt lgkmcnt(0)" ::: "memory")
__device__ __forceinline__ unsigned f2bf(float f) { unsigned u = __builtin_bit_cast(unsigned, f); return (u + 0x7fffu + ((u >> 16) & 1u)) >> 16; }
__device__ __forceinline__ unsigned pk2(float lo, float hi) { return f2bf(lo) | (f2bf(hi) << 16); }
__device__ __forceinline__ float bf_lo(unsigned u) { return __builtin_bit_cast(float, u << 16); }
__device__ __forceinline__ float bf_hi(unsigned u) { return __builtin_bit_cast(float, u & 0xffff0000u); }

namespace att {
__device__ __forceinline__ bf16x8 lds_rd(unsigned addr, const int off) { bf16x8 r; asm volatile("ds_read_b128 %0, %1 offset:%2" : "=v"(r) : "v"(addr), "i"(off) : "memory"); return r; }
__device__ __forceinline__ float xmax16(float x) { float a = x, b = x; asm volatile("s_nop 1\n\tv_permlane16_swap_b32 %0, %1\n\ts_nop 1" : "+v"(a), "+v"(b)); return fmaxf(a, b); }
__device__ __forceinline__ float xmax32(float x) { float a = x, b = x; asm volatile("s_nop 1\n\tv_permlane32_swap_b32 %0, %1\n\ts_nop 1" : "+v"(a), "+v"(b)); return fmaxf(a, b); }
template <int N> __device__ __forceinline__ void lgkm_pin(bf16x8& f) { (void)f; asm volatile("s_waitcnt lgkmcnt(%0)" :: "n"(N) : "memory"); }
template <int DV, int NMAP>
__device__ __forceinline__ void attn_unit(LAS unsigned char* lds, const bf16* __restrict__ QK, const bf16* __restrict__ VT, bf16* __restrict__ O,
                                          const int q0, const int hk0, const int vrow0, const int T0, const int T1, const bool band,
                                          const float* __restrict__ tabg, const float lam, const float outscale, const float* __restrict__ subg) {
    constexpr int STAGE = NMAP * 16384 + DV * 128, NPW = STAGE / 1024 / 8;
    static_assert(NPW == 4 || NPW == 8, "stage pieces per wave");
    int tid_ = threadIdx.x; asm volatile("" : "+v"(tid_));
    const int tid = tid_, wid = __builtin_amdgcn_readfirstlane(tid >> 6), lane = tid & 63, fr = lane & 15, fq = lane >> 4;
    const int qg = (NMAP == 2) ? (wid & 3) : wid, mp = (NMAP == 2) ? (wid >> 2) : 0;
    const int q0w = q0 + 32 * qg, cw = q0w >> 6, qoff = q0w & 63;
    const int lo_w = band ? (cw - 8 > 0 ? cw - 8 : 0) : 0;
    if (tid < 256) ((LAS float*)(lds + TAB_OFF))[tid] = (tid < 255) ? tabg[tid] : 0.f;
    bf16x8 q[2][4];
#pragma unroll
    for (int qb = 0; qb < 2; ++qb)
#pragma unroll
        for (int ks = 0; ks < 4; ++ks) q[qb][ks] = *(const bf16x8*)(QK + (size_t)(q0w + 16 * qb + fr) * QKLD + (hk0 + mp) * 128 + 32 * ks + 8 * fq);
    const int sbb = lane * 16, swz = sbb ^ (((sbb >> 9) & 1) << 5), rr = swz >> 6, cc = (swz & 63) >> 1;
    unsigned vbase; const char* gbase; size_t tstep; const bool isk = wid < 4;
    if (isk) { const int s = wid * NPW, mm = s >> 4, rem = s & 15, ch = rem >> 3, stt = rem & 7, R = 16 * (stt >> 1) + rr;
        const int key = (R & ~31) + pg8::perm32(R & 31), d = 64 * ch + 32 * (stt & 1) + cc;
        vbase = (unsigned)((key * QKLD + 2048 + (hk0 + mm) * 128 + d) * 2); gbase = (const char*)QK; tstep = (size_t)64 * QKLD * 2;
    } else { const int s = (wid - 4) * NPW, dv = 16 * (s >> 1) + rr, key = 32 * (s & 1) + cc;
        vbase = (unsigned)(((vrow0 + dv) * VTLD + key) * 2); gbase = (const char*)VT; tstep = (size_t)64 * 2; }
#define ATT_CJ(j_) (isk ? (size_t)(((32 * ((j_) >> 2) + 4 * (((j_) >> 1) & 1)) * QKLD + 32 * ((j_) & 1)) * 2) : (size_t)((16 * ((j_) >> 1) * VTLD + 32 * ((j_) & 1)) * 2))
#define ATT_STAGE(t_, buf_) do { const char* gb_ = gbase + (size_t)(t_) * tstep; _Pragma("unroll") for (int j_ = 0; j_ < NPW * REP_DMA; ++j_) \
        __builtin_amdgcn_global_load_lds((const unsigned*)(gb_ + ATT_CJ(j_ % NPW) + vbase), (LAS unsigned*)(lds + (buf_) * STAGE + (wid * NPW + j_ % NPW) * 1024), 16, 0, 0); } while (0)
    const int loff = (fr * 64 + fq * 16) ^ (((fr >> 3) & 1) << 5);
    f32x4 o[DV / 16][2];
#pragma unroll
    for (int db = 0; db < DV / 16; ++db) { o[db][0] = (f32x4){0.f, 0.f, 0.f, 0.f}; o[db][1] = (f32x4){0.f, 0.f, 0.f, 0.f}; }
    float lsum[2] = {0.f, 0.f};
    const LAS float* tab = (const LAS float*)(lds + TAB_OFF);
    asm volatile("s_waitcnt vmcnt(0)" ::: "memory");
    ATT_STAGE(T0, 0);
    if ((wid >> 2) ^ (wid & 1)) __builtin_amdgcn_s_setprio(2);
    for (int t = T0; t <= T1; ++t) {
        const int cur = (t - T0) & 1;
        asm volatile("s_waitcnt vmcnt(0)" ::: "memory");
        asm volatile("s_waitcnt lgkmcnt(0)" ::: "memory"); __builtin_amdgcn_s_barrier(); asm volatile("" ::: "memory");
        const bool inr = (t >= lo_w && t <= cw);
        if (t < T1 && (isk || !inr)) ATT_STAGE(t + 1, cur ^ 1);
        if (inr) {
            const LAS unsigned char* st = lds + cur * STAGE;
            f32x4 s[4][2];
#pragma unroll
            for (int kb = 0; kb < 4; ++kb) { s[kb][0] = (f32x4){0.f, 0.f, 0.f, 0.f}; s[kb][1] = (f32x4){0.f, 0.f, 0.f, 0.f}; }
            const unsigned stk = (unsigned)(size_t)(st + mp * 16384 + loff), stv = (unsigned)(size_t)(st + NMAP * 16384 + loff);
#define ATT_KLD(i_) lds_rd(stk, (((i_) >> 2) >> 1) * 8192 + (((i_) & 3) * 2 + (((i_) >> 2) & 1)) * 1024)
#define ATT_VLD(i_) lds_rd(stv, ((((i_) % (DV / 16)) * 2) + ((i_) / (DV / 16))) * 1024)
            { bf16x8 f0 = ATT_KLD(0), f1 = ATT_KLD(1), f2 = ATT_KLD(2);
#pragma unroll
              for (int i = 0; i < 16; ++i) {
                  bf16x8 cur = f0; f0 = f1; f1 = f2; if (i + 3 < 16) f2 = ATT_KLD(i + 3);
                  if (i + 3 < 16) lgkm_pin<3>(cur); else if (i + 2 < 16) lgkm_pin<2>(cur); else if (i + 1 < 16) lgkm_pin<1>(cur); else lgkm_pin<0>(cur);
                  __builtin_amdgcn_sched_barrier(0);
                  s[i & 3][0] = __builtin_amdgcn_mfma_f32_16x16x32_bf16(cur, q[0][i >> 2], s[i & 3][0], 0, 0, 0);
                  s[i & 3][1] = __builtin_amdgcn_mfma_f32_16x16x32_bf16(cur, q[1][i >> 2], s[i & 3][1], 0, 0, 0);
                  __builtin_amdgcn_sched_barrier(0);
              } }
            if (t < T1 && !isk) ATT_STAGE(t + 1, cur ^ 1);
            bf16x8 v0 = ATT_VLD(0), v1 = ATT_VLD(1), v2 = ATT_VLD(2);
            __builtin_amdgcn_sched_barrier(0);
            if (t >= cw - 2) {
                const int tb = 64 * (t - cw + 2) + 8 * fq + 63 - qoff - fr;
#pragma unroll
                for (int kb = 0; kb < 4; ++kb)
#pragma unroll
                    for (int qb = 0; qb < 2; ++qb)
#pragma unroll
                        for (int i = 0; i < 4; ++i) s[kb][qb][i] += tab[tb + 32 * (kb >> 1) + 4 * (kb & 1) + i - 16 * qb];
            }
            bf16x8 pf[2][2];
#pragma unroll
            for (int qb = 0; qb < 2; ++qb) {
#pragma unroll
                for (int kb = 0; kb < 2; ++kb)
#pragma unroll
                    for (int i = 0; i < 4; ++i) s[kb][qb][i] = __builtin_amdgcn_exp2f(s[kb][qb][i]);
                v4u w; w.x = pg8::cvt_pk_bf16(s[0][qb][0], s[0][qb][1]); w.y = pg8::cvt_pk_bf16(s[0][qb][2], s[0][qb][3]);
                w.z = pg8::cvt_pk_bf16(s[1][qb][0], s[1][qb][1]); w.w = pg8::cvt_pk_bf16(s[1][qb][2], s[1][qb][3]); pf[qb][0] = __builtin_bit_cast(bf16x8, w);
                pf[qb][1] = pf[qb][0];
            }
            __builtin_amdgcn_sched_barrier(0);
#pragma unroll
            for (int i = 0; i < 2 * (DV / 16); ++i) {
                constexpr int NV = 2 * (DV / 16), EPS = 16 / (NV / 2);
                if (i == NV / 2) {
#pragma unroll
                    for (int qb = 0; qb < 2; ++qb) {
                        v4u w; w.x = pg8::cvt_pk_bf16(s[2][qb][0], s[2][qb][1]); w.y = pg8::cvt_pk_bf16(s[2][qb][2], s[2][qb][3]);
                        w.z = pg8::cvt_pk_bf16(s[3][qb][0], s[3][qb][1]); w.w = pg8::cvt_pk_bf16(s[3][qb][2], s[3][qb][3]); pf[qb][1] = __builtin_bit_cast(bf16x8, w);
                        const f32x4 pa = (s[0][qb] + s[1][qb]) + (s[2][qb] + s[3][qb]);
                        lsum[qb] += (pa[0] + pa[1]) + (pa[2] + pa[3]);
                    }
                }
                bf16x8 cur = v0; v0 = v1; v1 = v2; if (i + 3 < NV) v2 = ATT_VLD(i + 3);
                if (i + 3 < NV) lgkm_pin<3>(cur); else if (i + 2 < NV) lgkm_pin<2>(cur); else if (i + 1 < NV) lgkm_pin<1>(cur); else lgkm_pin<0>(cur);
                __builtin_amdgcn_sched_barrier(0);
                o[i % (DV / 16)][0] = __builtin_amdgcn_mfma_f32_16x16x32_bf16(cur, pf[0][i / (DV / 16)], o[i % (DV / 16)][0], 0, 0, 0);
                o[i % (DV / 16)][1] = __builtin_amdgcn_mfma_f32_16x16x32_bf16(cur, pf[1][i / (DV / 16)], o[i % (DV / 16)][1], 0, 0, 0);
                if (i < NV / 2) {
#pragma unroll
                    for (int r_ = 0; r_ < EPS; ++r_) { const int e_ = i * EPS + r_; s[2 + (e_ >> 3)][(e_ >> 2) & 1][e_ & 3] = __builtin_amdgcn_exp2f(s[2 + (e_ >> 3)][(e_ >> 2) & 1][e_ & 3]); }
                }
                __builtin_amdgcn_sched_barrier(0);
            }
#undef ATT_KLD
#undef ATT_VLD
        }
    }
    __builtin_amdgcn_s_setprio(0);
    asm volatile("s_waitcnt lgkmcnt(0)" ::: "memory"); __builtin_amdgcn_s_barrier(); asm volatile("" ::: "memory");
#undef ATT_STAGE
#undef ATT_CJ
    float inv[2];
#pragma unroll
    for (int qb = 0; qb < 2; ++qb) { float l = lsum[qb]; l += __shfl_xor(l, 16); l += __shfl_xor(l, 32); inv[qb] = 1.0f / l; }
    if (NMAP == 1) {
#pragma unroll
        for (int qb = 0; qb < 2; ++qb) { bf16* rowp = O + (size_t)(q0w + 16 * qb + fr) * DM + vrow0 + 4 * fq;
#pragma unroll
            for (int db = 0; db < DV / 16; ++db) { const f32x4 v = o[db][qb] * inv[qb]; v2u w; w.x = pg8::cvt_pk_bf16(v[0], v[1]); w.y = pg8::cvt_pk_bf16(v[2], v[3]); *(v2u*)(rowp + 16 * db) = w; } }
    } else {
        LAS f32x4* xch = (LAS f32x4*)(lds + qg * 32768);
        if (mp == 1) {
#pragma unroll
            for (int db = 0; db < DV / 16; ++db)
#pragma unroll
                for (int qb = 0; qb < 2; ++qb) xch[(db * 2 + qb) * 64 + lane] = o[db][qb] * (inv[qb] * lam);
        }
        asm volatile("s_waitcnt lgkmcnt(0)" ::: "memory"); __builtin_amdgcn_s_barrier(); asm volatile("" ::: "memory");
        if (mp == 0) {
            float ss[2] = {0.f, 0.f};
#pragma unroll
            for (int db = 0; db < DV / 16; ++db)
#pragma unroll
                for (int qb = 0; qb < 2; ++qb) { const f32x4 x = o[db][qb] * inv[qb] - xch[(db * 2 + qb) * 64 + lane]; o[db][qb] = x; ss[qb] += (x[0] * x[0] + x[1] * x[1]) + (x[2] * x[2] + x[3] * x[3]); if (qb == 1 && (db & 1)) asm volatile("" ::: "memory"); }
#pragma unroll
            for (int qb = 0; qb < 2; ++qb) { float v = ss[qb]; v += __shfl_xor(v, 16); v += __shfl_xor(v, 32); ss[qb] = outscale / sqrtf(v * (1.0f / DV) + RMS_EPS); }
#pragma unroll
            for (int db = 0; db < DV / 16; ++db) { const f32x4 g = *(const f32x4*)(subg + 16 * db + 4 * fq);
#pragma unroll
                for (int qb = 0; qb < 2; ++qb) { const f32x4 v = o[db][qb] * g * ss[qb]; v2u w; w.x = pg8::cvt_pk_bf16(v[0], v[1]); w.y = pg8::cvt_pk_bf16(v[2], v[3]);
                    *(v2u*)(O + (size_t)(q0w + 16 * qb + fr) * DM + vrow0 + 16 * db + 4 * fq) = w; } }
        }
        asm volatile("s_waitcnt lgkmcnt(0)" ::: "memory"); __builtin_amdgcn_s_barrier(); asm volatile("" ::: "memory");
    }
}
}

#define GAS __attribute__((address_space(1)))
__device__ __forceinline__ float wave_sum(float v) {
#pragma unroll
    for (int o = 1; o < 64; o <<= 1) v += __shfl_xor(v, o);
    return v;
}
__device__ __forceinline__ void p0_transpose_item(const float* W, int K, int N, bf16* WT, int row_off, LAS float* scr, int item, int lane) {
    const int nblk = N / 32, kb = item / nblk, nb = item % nblk, k0 = 64 * kb, n0 = 32 * nb;
#pragma unroll 8
    for (int i = 0; i < 32; ++i) { const int kk = 2 * i + (lane >> 5); scr[kk * 33 + (lane & 31)] = W[(size_t)(k0 + kk) * N + n0 + (lane & 31)]; }
    LDS_WAIT(); asm volatile("" ::: "memory");
    const int c = lane & 7;
#pragma unroll
    for (int j = 0; j < 4; ++j) { const int n = (lane >> 3) + 8 * j; const LAS float* s = scr + (8 * c) * 33 + n;
        v4u o; o.x = pk2(s[0 * 33], s[1 * 33]); o.y = pk2(s[2 * 33], s[3 * 33]); o.z = pk2(s[4 * 33], s[5 * 33]); o.w = pk2(s[6 * 33], s[7 * 33]);
        *(GAS v4u*)(WT + (size_t)(row_off + n0 + n) * K + k0 + 8 * c) = o; }
    LDS_WAIT(); asm volatile("" ::: "memory");
}
__device__ __forceinline__ void p0_transpose_item_g(const float* W, int K, int N, bf16* WT, LAS float* scr, int item, int lane, const float* gk) {
    const int nblk = N / 32, kb = item / nblk, nb = item % nblk, k0 = 64 * kb, n0 = 32 * nb;
    const int c = lane & 7;
    f32x4 g0 = {1.f, 1.f, 1.f, 1.f}, g1 = g0;
    if (gk) { g0 = *(const f32x4*)(gk + k0 + 8 * c); g1 = *(const f32x4*)(gk + k0 + 8 * c + 4); }
#pragma unroll 8
    for (int i = 0; i < 32; ++i) { const int kk = 2 * i + (lane >> 5); scr[kk * 33 + (lane & 31)] = W[(size_t)(k0 + kk) * N + n0 + (lane & 31)]; }
    LDS_WAIT(); asm volatile("" ::: "memory");
#pragma unroll
    for (int j = 0; j < 4; ++j) { const int n = (lane >> 3) + 8 * j; const LAS float* sp = scr + (8 * c) * 33 + n;
        v4u o; o.x = pk2(sp[0 * 33] * g0[0], sp[1 * 33] * g0[1]); o.y = pk2(sp[2 * 33] * g0[2], sp[3 * 33] * g0[3]); o.z = pk2(sp[4 * 33] * g1[0], sp[5 * 33] * g1[1]); o.w = pk2(sp[6 * 33] * g1[2], sp[7 * 33] * g1[3]);
        *(GAS v4u*)(WT + (size_t)(n0 + n) * K + k0 + 8 * c) = o; }
    LDS_WAIT(); asm volatile("" ::: "memory");
}
__device__ __forceinline__ int t5_bucket(int rel) {
    const int ret = rel > 0 ? 16 : 0, n = rel < 0 ? -rel : rel;
    if (n < 8) return ret + n;
    int large = 8 + (31 - __builtin_clz((unsigned)(n * n))) - 6;
    if (large > 15) large = 15;
    return ret + large;
}
template <bool HIN_BF16, bool HOUT_BF16>
__device__ __forceinline__ void norm_rows(const bf16* __restrict__ Y, const void* Hin, void* H, const float* __restrict__ gpost, float* __restrict__ RSout, int gw, int NGW, int lane) {
    for (int m = gw; m < SEQ; m += NGW) {
        f32x4 h[8];
        if (HIN_BF16) {
#pragma unroll
            for (int j = 0; j < 4; ++j) { const v4u w = *(const v4u*)((const bf16*)Hin + (size_t)m * DM + 512 * j + 8 * lane);
                h[2 * j] = (f32x4){bf_lo(w[0]), bf_hi(w[0]), bf_lo(w[1]), bf_hi(w[1])}; h[2 * j + 1] = (f32x4){bf_lo(w[2]), bf_hi(w[2]), bf_lo(w[3]), bf_hi(w[3])}; }
        } else {
            const float* hr = (const float*)Hin + (size_t)m * DM + 8 * lane;
#pragma unroll
            for (int j = 0; j < 4; ++j) { h[2 * j] = *(const f32x4*)(hr + 512 * j); h[2 * j + 1] = *(const f32x4*)(hr + 512 * j + 4); }
        }
        if (Y) {
            v4u y[4]; float ss = 0.f;
#pragma unroll
            for (int j = 0; j < 4; ++j) y[j] = *(const v4u*)(Y + (size_t)m * DM + 512 * j + 8 * lane);
#pragma unroll
            for (int j = 0; j < 4; ++j)
#pragma unroll
                for (int e = 0; e < 4; ++e) { const float a = bf_lo(y[j][e]), b = bf_hi(y[j][e]); ss += a * a + b * b; }
            const float rs = 1.0f / sqrtf(wave_sum(ss) * (1.0f / DM) + RMS_EPS);
#pragma unroll
            for (int j = 0; j < 4; ++j) { const f32x4 g0 = *(const f32x4*)(gpost + 512 * j + 8 * lane), g1 = *(const f32x4*)(gpost + 512 * j + 8 * lane + 4);
                f32x4 a = {bf_lo(y[j][0]), bf_hi(y[j][0]), bf_lo(y[j][1]), bf_hi(y[j][1])}, b = {bf_lo(y[j][2]), bf_hi(y[j][2]), bf_lo(y[j][3]), bf_hi(y[j][3])};
                h[2 * j] = h[2 * j] + a * g0 * rs; h[2 * j + 1] = h[2 * j + 1] + b * g1 * rs; }
        }
        if (HOUT_BF16) {
#pragma unroll
            for (int j = 0; j < 4; ++j) { v4u w; w.x = pk2(h[2 * j][0], h[2 * j][1]); w.y = pk2(h[2 * j][2], h[2 * j][3]); w.z = pk2(h[2 * j + 1][0], h[2 * j + 1][1]); w.w = pk2(h[2 * j + 1][2], h[2 * j + 1][3]);
                *(v4u*)((bf16*)H + (size_t)m * DM + 512 * j + 8 * lane) = w; }
        } else { float* ho = (float*)H + (size_t)m * DM + 8 * lane;
#pragma unroll
            for (int j = 0; j < 4; ++j) { *(f32x4*)(ho + 512 * j) = h[2 * j]; *(f32x4*)(ho + 512 * j + 4) = h[2 * j + 1]; } }
        if (RSout) {
            float ss = 0.f;
#pragma unroll
            for (int j = 0; j < 8; ++j) ss += (h[j][0] * h[j][0] + h[j][1] * h[j][1]) + (h[j][2] * h[j][2] + h[j][3] * h[j][3]);
            const float rs = 1.0f / sqrtf(wave_sum(ss) * (1.0f / DM) + RMS_EPS);
            if (lane == 0) RSout[m] = rs;
        }
    }
}

#define XB_TMO      128
#define XB_XCNT(j)  (256  + 64 * (j))
#define XB_XSUB(j)  (1280 + 64 * (j))
#define XB_XGEN(j)  (2304 + 64 * (j))
#define XB_TOP      3328
#define XB_TOPGEN   3392
#define XCD_BAR_WORDS 3456
#define XB_SPIN_CAP (1u << 18)

__device__ __forceinline__ unsigned xb_ld(unsigned* p)              { return __hip_atomic_load(p, __ATOMIC_RELAXED, __HIP_MEMORY_SCOPE_AGENT); }
__device__ __forceinline__ unsigned xb_add(unsigned* p, unsigned v) { return __hip_atomic_fetch_add(p, v, __ATOMIC_RELAXED, __HIP_MEMORY_SCOPE_AGENT); }
__device__ __forceinline__ unsigned xb_xcc_id() { return (unsigned)__builtin_amdgcn_s_getreg((3 << 11) | 20) & 0xFu; }
#define XB_SPIN(cond, bar) do { unsigned _sp = 0; while (cond) { __builtin_amdgcn_s_sleep(1); \
    if ((++_sp & 255u) == 0u) { if (xb_ld(&(bar)[XB_TMO])) break; if (_sp > XB_SPIN_CAP) { atomicAdd(&(bar)[XB_TMO], 1u); break; } } } } while (0)

struct XcdBarrier {
    unsigned* bar; unsigned x;
    volatile LAS unsigned* st;
};

__device__ __forceinline__ XcdBarrier xcd_barrier_post(unsigned* bar, volatile LAS unsigned* st) {
    XcdBarrier b; b.bar = bar; b.x = xb_xcc_id(); b.st = st;
    if (threadIdx.x == 0) (void)xb_add(&bar[XB_XCNT(b.x)], 1u);
    return b;
}
__device__ __forceinline__ void xcd_barrier_complete(unsigned* bar, unsigned x, unsigned& nloc, unsigned& nx) {
    const unsigned G = gridDim.x * gridDim.y * gridDim.z;
    unsigned sum, cnt, mine, sp = 0u;
    for (;;) {
        sum = 0u; cnt = 0u; mine = 0u;
#pragma unroll
        for (unsigned j = 0; j < 16; ++j) { const unsigned c = xb_ld(&bar[XB_XCNT(j)]); sum += c; cnt += (c > 0u) ? 1u : 0u; mine = (j == x) ? c : mine; }
        if (sum == G) break;
        __builtin_amdgcn_s_sleep(1);
        if ((++sp & 255u) == 0u) { if (xb_ld(&bar[XB_TMO])) break; if (sp > XB_SPIN_CAP) { atomicAdd(&bar[XB_TMO], 1u); break; } }
    }
    nloc = mine > 0u ? mine : 1u; nx = cnt > 0u ? cnt : 1u;
}

__device__ __forceinline__ void xcd_barrier(const XcdBarrier& b) {
    asm volatile("s_waitcnt vmcnt(0)" ::: "memory");
    __syncthreads();
    if (threadIdx.x == 0) {
        unsigned* bar = b.bar;
        __builtin_amdgcn_s_waitcnt(0);
        unsigned nloc = b.st[0], nx = b.st[1];
        if (nloc == 0u) { xcd_barrier_complete(bar, b.x, nloc, nx); b.st[0] = nloc; b.st[1] = nx; }
        const unsigned old = xb_add(&bar[XB_XSUB(b.x)], 1u);
        const unsigned gen = old / nloc;
        if (old + 1u == (gen + 1u) * nloc) {
            __builtin_amdgcn_fence(__ATOMIC_RELEASE, "agent");
            asm volatile("s_waitcnt vmcnt(0)" ::: "memory");
            const unsigned og = xb_add(&bar[XB_TOP], 1u);
            const unsigned tg = og / nx;
            if (og + 1u == (tg + 1u) * nx) xb_add(&bar[XB_TOPGEN], 1u);
            else XB_SPIN(xb_ld(&bar[XB_TOPGEN]) == tg, bar);
            __builtin_amdgcn_fence(__ATOMIC_ACQUIRE, "agent");
            xb_add(&bar[XB_XGEN(b.x)], 1u);
            asm volatile("s_waitcnt vmcnt(0)" ::: "memory");
        } else {
            XB_SPIN(xb_ld(&bar[XB_XGEN(b.x)]) == gen, bar);
            __builtin_amdgcn_fence(__ATOMIC_ACQUIRE, "agent");
            asm volatile("s_waitcnt vmcnt(0)" ::: "memory");
        }
    }
    __syncthreads();
}
struct Args { const float* in[12]; float* out; unsigned char* ws; float lam_init[2]; int ph_lo, ph_hi; };
static_assert(sizeof(Args) == 128, "Args has no padding");
enum { IN_X = 0, IN_NORMG, IN_AQKV, IN_AO, IN_ABIAS, IN_BQKV, IN_BO, IN_BLAM, IN_BSUB, IN_T5, IN_UP, IN_DOWN };

__global__ void __launch_bounds__(512, 2) trunk_fwd(Args a) {
    extern __shared__ __attribute__((aligned(16))) unsigned char lds_raw[];
    LAS unsigned char* lds = (LAS unsigned char*)lds_raw;
    cg::grid_group grid = cg::this_grid();
    const int wave = __builtin_amdgcn_readfirstlane((int)threadIdx.x >> 6);
    const int G = gridDim.x, bx = blockIdx.x;
#define FRESH_TID() int tid = threadIdx.x; asm volatile("" : "+v"(tid)); const int lane = tid & 63
    const int gw = bx * 8 + wave, NGW = G * 8;
#define FRESH_WS() unsigned long long wz_ = 0; asm volatile("" : "+s"(wz_)); unsigned char* ws = a.ws + wz_; bf16* XN = (bf16*)(ws + WS_XN); bf16* QK = (bf16*)(ws + WS_QK); bf16* VT = (bf16*)(ws + WS_VT); bf16* OB = (bf16*)(ws + WS_O); \
    bf16* UB = (bf16*)(ws + WS_U); bf16* YB = (bf16*)(ws + WS_Y); float* TAB = (float*)(ws + WS_TAB); const float* normg = (const float*)(ws + WS_NORMG); \
    (void)XN; (void)QK; (void)VT; (void)OB; (void)UB; (void)YB; (void)TAB; (void)normg
    if (threadIdx.x < 4) ((LAS unsigned*)(lds + XBST_OFF))[threadIdx.x] = 0u;
    __syncthreads();
    XcdBarrier xbar; xbar.bar = (unsigned*)(a.ws + WS_BAR); xbar.x = 0; xbar.st = (volatile LAS unsigned*)(lds + XBST_OFF);
    int ph = 0;
#define RUN() (a.ph_lo <= ph && ph < a.ph_hi)
#ifndef REP_SYNC
#define REP_SYNC 1
#endif
#define SEAM() do { if (a.ph_lo <= ph && ph + 1 < a.ph_hi) { if (ph == 0) { grid.sync(); xbar = xcd_barrier_post((unsigned*)(a.ws + WS_BAR), (volatile LAS unsigned*)(lds + XBST_OFF)); } else xcd_barrier(xbar); } ++ph; } while (0)

    if (RUN()) {
        FRESH_TID(); FRESH_WS();
        if (bx == 0) for (int e = tid; e < (int)(BAR_BYTES / 4); e += 512) ((unsigned*)(ws + WS_BAR))[e] = 0u;
        LAS float* scr = (LAS float*)(lds + wave * 16384);
        constexpr int I_QKV = (DM / 64) * (3 * DM / 32), I_O = (DM / 64) * (DM / 32), I_UP = (DM / 64) * (DFF / 32), I_DN = (DFF / 64) * (DM / 32), I_LAYER = I_QKV + I_O + I_UP + I_DN;
        for (int rep = 0; rep < REP_P0; ++rep)
        for (int it = gw; it < DEPTH * I_LAYER; it += NGW) {
            const int L = it / I_LAYER; int r = it % I_LAYER; const int i = L >> 1;
            bf16* wl = (bf16*)(ws + WS_W + (size_t)L * W_LAYER);
            if (r < I_QKV) { p0_transpose_item_g(((L & 1) ? a.in[IN_BQKV] : a.in[IN_AQKV]) + (size_t)i * DM * 3 * DM, DM, 3 * DM, wl + W_QKV / 2, scr, r, lane, a.in[IN_NORMG] + (size_t)(L * 4 + 0) * DM); continue; } r -= I_QKV;
            if (r < I_O) { p0_transpose_item_g(((L & 1) ? a.in[IN_BO] : a.in[IN_AO]) + (size_t)i * DM * DM, DM, DM, wl + W_O / 2, scr, r, lane, nullptr); continue; } r -= I_O;
            if (r < I_UP) { p0_transpose_item_g(a.in[IN_UP] + (size_t)L * DM * DFF, DM, DFF, wl + W_UP / 2, scr, r, lane, a.in[IN_NORMG] + (size_t)(L * 4 + 2) * DM); continue; } r -= I_UP;
            p0_transpose_item_g(a.in[IN_DOWN] + (size_t)L * DFF * DM, DFF, DM, wl + W_DOWN / 2, scr, r, lane, nullptr);
        }
        for (int e = bx * 512 + tid; e < (2 * 16 + 8) * 256; e += G * 512) {
            const int idx = e & 255, hh = e >> 8, rel = idx - 191; float v = 0.f;
            if (idx < 255) {
                if (hh < 32) { const int i = hh >> 4, h = hh & 15; const float* rb = a.in[IN_ABIAS] + (size_t)i * 257 * 16; int c = rel < -128 ? -128 : (rel > 128 ? 128 : rel);
                    v = (rb[(c + 128) * 16 + h] - rb[h]) * LOG2E; }
                else { const int h = hh - 32; const float* t5 = a.in[IN_T5]; v = (t5[t5_bucket(rel) * 8 + h] - t5[15 * 8 + h]) * LOG2E; }
            }
            TAB[e] = v;
        }
        for (int e = bx * 512 + tid; e < DEPTH * 4 * DM; e += G * 512) ((float*)(ws + WS_NORMG))[e] = a.in[IN_NORMG][e];
        for (int e = bx * 512 + tid; e < 2 * 4 * 128; e += G * 512) ((float*)(ws + WS_BLAM))[e] = a.in[IN_BLAM][e];
        for (int e = bx * 512 + tid; e < 2 * 256; e += G * 512) ((float*)(ws + WS_BSUB))[e] = a.in[IN_BSUB][e];
        norm_rows<false, true>(nullptr, a.in[IN_X], ws + WS_HB, nullptr, (float*)(ws + WS_RS), gw, NGW, lane);
    }
    SEAM();

    for (int L = 0; L < DEPTH; ++L) {
        if (RUN()) {
            FRESH_WS(); const bf16* wl = (const bf16*)(ws + WS_W + (size_t)L * W_LAYER);
            { pg8::Gemm g{(const bf16*)(ws + WS_HB), wl + W_QKV / 2, SEQ, 2 * DM, DM}; pg8::StaticOrder S; S.init(SEQ, 2 * DM, G, bx);
              pg8::EpiBf16<0> E{QK, QKLD, DM, 0.08838834764831845f * LOG2E, (const float*)(ws + WS_RS), 1};
              pg8::gemm_phase<pg8::EpiBf16<0>, pg8::StaticOrder, true, true>(lds, g, S, E); }
            { pg8::Gemm g{wl + W_QKV / 2 + (size_t)2 * DM * DM, (const bf16*)(ws + WS_HB), DM, SEQ, DM}; pg8::StaticOrder S; S.init(DM, SEQ, G, bx);
              pg8::EpiBf16<0> E{VT, VTLD, 0, 1.f, (const float*)(ws + WS_RS), 2};
              pg8::gemm_phase<pg8::EpiBf16<0>, pg8::StaticOrder, true, true>(lds, g, S, E); }
        }
        SEAM();
        if (RUN()) {
            FRESH_WS(); int u0 = bx; asm volatile("" : "+s"(u0));
            if ((L & 1) == 0) {
                const float* tabA = TAB + (size_t)(L >> 1) * 16 * 256;
                for (int rep = 0; rep < REP_ATTA; ++rep)
                for (int u = u0; u < 64 * 16; u += G) {
                    const int h = u & 15, qblk = u >> 4, c0 = 4 * qblk;
#ifndef NO_ATTA
                    att::attn_unit<128, 1>(lds, QK, VT, OB, 256 * qblk, h, 128 * h, (c0 - 8 > 0 ? c0 - 8 : 0), c0 + 3, true, tabA + h * 256, 0.f, 1.f, nullptr);
#endif
                }
            } else {
                FRESH_TID(); (void)tid;
                const int i = L >> 1;
                const float* lf = (const float*)(ws + WS_BLAM) + (size_t)i * 4 * 128;
                const float s1 = wave_sum(lf[lane] * lf[128 + lane] + lf[64 + lane] * lf[192 + lane]), s2 = wave_sum(lf[256 + lane] * lf[384 + lane] + lf[320 + lane] * lf[448 + lane]);
                const float li = a.lam_init[i], lam = expf(s1) - expf(s2) + li;
                const float* tabB = TAB + (size_t)32 * 256;
                for (int rep = 0; rep < REP_ATTB; ++rep)
                for (int u = u0; u < 128 * 8; u += G) {
                    const int h = u & 7, j = u >> 3, ii = j & 31, r = j >> 5;
                    const int qblk = (r == 0) ? 127 - ii : (r == 1) ? 64 + ii : (r == 2) ? 63 - ii : ii;
#ifndef NO_ATTB
                    att::attn_unit<256, 2>(lds, QK, VT, OB, 128 * qblk, 2 * h, 256 * h, 0, 2 * qblk + 1, false, tabB + h * 256, lam, 1.0f - li, (const float*)(ws + WS_BSUB) + (size_t)i * 256);
#endif
                }
            }
        }
        SEAM();
        if (RUN()) {
            FRESH_WS(); const bf16* wl = (const bf16*)(ws + WS_W + (size_t)L * W_LAYER);
            pg8::Gemm g{OB, wl + W_O / 2, SEQ, DM, DM}; pg8::StaticOrder S; S.init(SEQ, DM, G, bx);
            pg8::EpiBf16<0> E{YB, DM, 0, 1.f, nullptr, 0};
            pg8::gemm_phase<pg8::EpiBf16<0>, pg8::StaticOrder, true, true>(lds, g, S, E);
        }
        SEAM();
        if (RUN()) { FRESH_TID(); (void)tid; FRESH_WS(); const float* gL = normg + (size_t)L * 4 * DM; norm_rows<true, true>(YB, ws + WS_HB, ws + WS_HB, gL + DM, (float*)(ws + WS_RS), gw, NGW, lane); }
        SEAM();
        if (RUN()) {
            FRESH_WS(); const bf16* wl = (const bf16*)(ws + WS_W + (size_t)L * W_LAYER);
            for (int rep = 0; rep < REP_UP; ++rep) {
            pg8::Gemm g{(const bf16*)(ws + WS_HB), wl + W_UP / 2, SEQ, DFF, DM}; pg8::StaticOrder S; S.init(SEQ, DFF, G, bx);
            pg8::EpiBf16<2> E{UB, DFF, 0, 1.f, (const float*)(ws + WS_RS), 1};
            pg8::gemm_phase<pg8::EpiBf16<2>, pg8::StaticOrder, true, true>(lds, g, S, E);
            }
        }
        SEAM();
        if (RUN()) {
            FRESH_WS(); const bf16* wl = (const bf16*)(ws + WS_W + (size_t)L * W_LAYER);
            pg8::Gemm g{UB, wl + W_DOWN / 2, SEQ, DM, DFF}; pg8::StaticOrder S; S.init(SEQ, DM, G, bx);
            pg8::EpiBf16<0> E{YB, DM, 0, 1.f, nullptr, 0};
            pg8::gemm_phase<pg8::EpiBf16<0>, pg8::StaticOrder, true, true>(lds, g, S, E);
        }
        SEAM();
        if (RUN()) { FRESH_TID(); (void)tid; FRESH_WS(); const float* gL = normg + (size_t)L * 4 * DM; if (L + 1 < DEPTH) norm_rows<true, true>(YB, ws + WS_HB, ws + WS_HB, gL + 3 * DM, (float*)(ws + WS_RS), gw, NGW, lane);
            else norm_rows<true, false>(YB, ws + WS_HB, a.out, gL + 3 * DM, nullptr, gw, NGW, lane); }
        SEAM();
    }
#undef RUN
#undef SEAM
}
constexpr int N_PHASES = 1 + 7 * DEPTH;

extern "C" void kernel_launch(void* const* d_in, const int* in_sizes, int n_in, void* d_out, int out_size, void* d_ws, size_t ws_size, hipStream_t stream) {
    static int grid = 0;
    if (grid == 0) {
        if (n_in != 12 || in_sizes[0] != SEQ * DM || out_size != SEQ * DM || ws_size < WS_END) { fprintf(stderr, "kernel_launch: unexpected shapes (n_in %d, ws %zu); nothing launched\n", n_in, ws_size); grid = -1; return; }
        int dev = 0, cus = 0, per_cu = 0;
        if (hipGetDevice(&dev) != hipSuccess || hipDeviceGetAttribute(&cus, hipDeviceAttributeMultiprocessorCount, dev) != hipSuccess) { grid = -1; return; }
        if (hipFuncSetAttribute((const void*)trunk_fwd, hipFuncAttributeMaxDynamicSharedMemorySize, LDS_BYTES) != hipSuccess) { fprintf(stderr, "kernel_launch: hipFuncSetAttribute failed\n"); grid = -1; return; }
        if (hipOccupancyMaxActiveBlocksPerMultiprocessor(&per_cu, (const void*)trunk_fwd, 512, LDS_BYTES) != hipSuccess || per_cu < 1) { fprintf(stderr, "kernel_launch: occupancy query says %d blocks per CU\n", per_cu); per_cu = 1; }
        (void)hipGetLastError();
        grid = cus;
    }
    if (grid < 0) return;
    Args a{};
    for (int i = 0; i < 12; ++i) a.in[i] = (const float*)d_in[i];
    a.out = (float*)d_out; a.ws = (unsigned char*)d_ws;
    a.lam_init[0] = (float)(0.8 - 0.6 * exp(-0.3 * 1.0)); a.lam_init[1] = (float)(0.8 - 0.6 * exp(-0.3 * 3.0));
    if (ONE_LAUNCH) {
        a.ph_lo = 0; a.ph_hi = N_PHASES;
        void* args[] = {&a};
        hipError_t e = hipLaunchCooperativeKernel((const void*)trunk_fwd, dim3(grid), dim3(512), args, LDS_BYTES, stream);
        if (e != hipSuccess) fprintf(stderr, "kernel_launch: cooperative launch failed: %s (grid %d)\n", hipGetErrorString(e), grid);
    } else {
        for (int p = 0; p < N_PHASES; ++p) { a.ph_lo = p; a.ph_hi = p + 1; hipLaunchKernelGGL(trunk_fwd, dim3(grid), dim3(512), LDS_BYTES, stream, a); }
    }
}
```

```cpp
#include <hip/hip_runtime.h>
#include <hip/hip_cooperative_groups.h>
#include <cstdio>
#include <cstdint>
#include <cmath>
namespace cg = cooperative_groups;
#ifndef MK_ONE_LAUNCH
#define MK_ONE_LAUNCH 1
#endif
namespace pg8 {
#define PG8_LAS __attribute__((address_space(3)))
typedef unsigned short bf16_t;
typedef short bf16x8 __attribute__((ext_vector_type(8)));
typedef float f32x4 __attribute__((ext_vector_type(4)));
typedef unsigned u32x4 __attribute__((ext_vector_type(4)));
constexpr int BM = 256, BK = 64, HALF = 128, HTB = HALF * BK * 2  , STAGE_BYTES = 8 * HTB, NXCD = 8, WGM = 8;

__host__ __device__ __forceinline__ int lds_byte(int r, int c) { const int st = (r >> 4) * 2 + (c >> 5), rr = r & 15, cc = c & 31, ob = rr * 64 + cc * 2; return st * 1024 + (ob ^ (((ob >> 9) & 1) << 5)); }
__host__ __device__ __forceinline__ void stage_rc(int b, int& R, int& C) { const int st = b / 1024, sb = b % 1024, swz = sb ^ (((sb >> 9) & 1) << 5); R = (st >> 1) * 16 + swz / 64; C = (st & 1) * 32 + (swz % 64) / 2; }
__host__ __device__ __forceinline__ int perm32(int rho) { const int n = rho >> 4, i = rho & 15; return 8 * (i >> 2) + 4 * n + (i & 3); }

struct Unit { int pm, pn; };
struct Gemm { const bf16_t* A; const bf16_t* Bt; int M, N, K; };

struct StaticOrder {
    int nM, nN, nwg, G, c;
    __host__ __device__ void init(int M, int N, int G_, int c_) { nM = M / BM; nN = N / BM; nwg = nM * nN; G = G_; c = c_; }
    __host__ __device__ bool next(int i, Unit& u) const {
        const long L = (long)i * G + c; if (L >= nwg) return false;
        int wgid = (int)L; { const int q = nwg / NXCD, r = nwg % NXCD, xcd = wgid % NXCD, off = wgid / NXCD; wgid = (xcd < r ? xcd * (q + 1) : r * (q + 1) + (xcd - r) * q) + off; }
        const int nig = WGM * nN, gid = wgid / nig, fm = gid * WGM, gsz = (nM - fm) < WGM ? (nM - fm) : WGM;
        u.pm = fm + ((wgid % nig) % gsz); u.pn = (wgid % nig) / gsz; return true;
    }
    __device__ __forceinline__ void a_ready(const Unit&) const {}
    __device__ __forceinline__ void done(const Unit&) const {}
};

__device__ __forceinline__ unsigned cvt_pk_bf16(float lo, float hi) { unsigned r; asm volatile("v_cvt_pk_bf16_f32 %0, %1, %2" : "=v"(r) : "v"(lo), "v"(hi)); return r; }
typedef float f32x2 __attribute__((ext_vector_type(2)));
template <int ACT  > struct EpiBf16 {
    static constexpr bool PERM = true, AFTER_DRAIN = false;
    bf16_t* O; int ldc; int scale_cols; float scale0; const float* rs; int rsmode;
    __device__ __forceinline__ void operator()(const f32x4 (&acc)[2][2][4][2], const Unit& u, int wr, int wc, int fr, int fq) const {
        const int row0 = u.pm * BM + wr * 64 + fr; const int colt = u.pn * BM;
        const float sc = (colt < scale_cols) ? scale0 : 1.f;
        const int col0 = colt + wc * 32 + 8 * fq;
        f32x4 cs[2][2];
#pragma unroll
        for (int bj = 0; bj < 2; ++bj) { cs[bj][0] = (f32x4){1.f, 1.f, 1.f, 1.f}; cs[bj][1] = cs[bj][0]; if (rsmode == 2) { cs[bj][0] = *(const f32x4*)(rs + col0 + bj * HALF); cs[bj][1] = *(const f32x4*)(rs + col0 + bj * HALF + 4); } }
#pragma unroll
        for (int ai = 0; ai < 2; ++ai)
#pragma unroll
            for (int m = 0; m < 4; ++m) { bf16_t* rowp = O + (size_t)(row0 + ai * HALF + m * 16) * ldc + col0;
                float rsc = sc; if (rsmode == 1) { const float r_ = rs[row0 + ai * HALF + m * 16]; rsc = sc * (ACT == 2 ? r_ * r_ : r_); }
#pragma unroll
                for (int bj = 0; bj < 2; ++bj) { f32x4 v0 = acc[ai][bj][m][0], v1 = acc[ai][bj][m][1];
                    if (ACT == 2) {
#pragma unroll
                        for (int e = 0; e < 4; ++e) { const float a0 = fmaxf(v0[e], 0.f), a1 = fmaxf(v1[e], 0.f); v0[e] = a0 * a0; v1[e] = a1 * a1; } }
                    v0 = v0 * cs[bj][0] * rsc; v1 = v1 * cs[bj][1] * rsc; u32x4 w; w.x = cvt_pk_bf16(v0[0], v0[1]); w.y = cvt_pk_bf16(v0[2], v0[3]); w.z = cvt_pk_bf16(v1[0], v1[1]); w.w = cvt_pk_bf16(v1[2], v1[3]);
                    *(u32x4*)(rowp + bj * HALF) = w; } }
    }
};
template <class Epi, class Sched, bool ALIGN_EPI = false, bool SP2 = false>
__device__ __forceinline__ void gemm_phase(PG8_LAS unsigned char* lds, const Gemm g, const Sched& S, const Epi& E) {
    int tid_ = threadIdx.x; asm volatile("" : "+v"(tid_));
    const int tid = tid_, wid = __builtin_amdgcn_readfirstlane(tid >> 6), lane = tid & 63, wr = wid >> 2, wc = wid & 3, fr = lane & 15, fq = lane >> 4;
    const int K = g.K, nt = K / BK;
    unsigned voffA[2], voffB[2];
#pragma unroll
    for (int i = 0; i < 2; ++i) { int R, C; stage_rc(tid * 16 + i * 8192, R, C); const int Rb = Epi::PERM ? ((R & ~31) + perm32(R & 31)) : R;
        voffA[i] = (unsigned)(R * K + C) * 2u; voffB[i] = (unsigned)(Rb * K + C) * 2u; }
    const size_t kstep = (size_t)(BK * 2);
    const size_t hstep = (size_t)HALF * K * 2;
    const size_t tstep = 2 * hstep;
    const unsigned ldsw = (unsigned)wid * 1024u;
    const int aoff = lds_byte(wr * 64 + fr, fq * 8), boff = lds_byte(wc * 32 + fr, fq * 8);
#define PG8_SA(b, h) (((b) * 2 + (h)) * HTB)
#define PG8_SB(b, h) ((4 + (b) * 2 + (h)) * HTB)
#define PG8_STAGE(bufoff, gbase, voff) do { _Pragma("unroll") for (int _i = 0; _i < 2; ++_i) \
        __builtin_amdgcn_global_load_lds((const unsigned*)((const char*)(gbase) + (voff)[_i]), (PG8_LAS unsigned*)(lds + (bufoff) + ldsw + _i * 8192), 16, 0, 0); } while (0)
#define PG8_LDA(dst, b, h) do { _Pragma("unroll") for (int m = 0; m < 4; ++m) _Pragma("unroll") for (int k = 0; k < 2; ++k) dst[m][k] = *(const PG8_LAS bf16x8*)(lds + PG8_SA(b, h) + aoff + m * 2048 + k * 1024); } while (0)
#define PG8_LDB(dst, b, h) do { _Pragma("unroll") for (int n = 0; n < 2; ++n) _Pragma("unroll") for (int k = 0; k < 2; ++k) dst[n][k] = *(const PG8_LAS bf16x8*)(lds + PG8_SB(b, h) + boff + n * 2048 + k * 1024); } while (0)
#define PG8_MMA(ai, bj, At, Bt) do { __builtin_amdgcn_s_setprio(1); _Pragma("unroll") for (int m = 0; m < 4; ++m) _Pragma("unroll") for (int n = 0; n < 2; ++n) _Pragma("unroll") for (int k = 0; k < 2; ++k) \
        acc[ai][bj][m][n] = __builtin_amdgcn_mfma_f32_16x16x32_bf16(Bt[n][k], At[m][k], acc[ai][bj][m][n], 0, 0, 0); __builtin_amdgcn_s_setprio(0); } while (0)
#define PG8_WAIT_V(n) asm volatile("s_waitcnt vmcnt(" #n ")" ::: "memory")
#define PG8_WAIT_L(n) asm volatile("s_waitcnt lgkmcnt(" #n ")" ::: "memory")
#define PG8_BAR __builtin_amdgcn_s_barrier()
#define PG8_SCHED __builtin_amdgcn_sched_barrier(0)
    Unit cur, nxt; int ui = 0;
    if (!S.next(0, cur)) return;
    f32x4 acc[2][2][4][2];
#pragma unroll
    for (int a = 0; a < 2; ++a)
#pragma unroll
        for (int b = 0; b < 2; ++b)
#pragma unroll
            for (int m = 0; m < 4; ++m)
#pragma unroll
                for (int n = 0; n < 2; ++n) acc[a][b][m][n] = (f32x4){0.f, 0.f, 0.f, 0.f};
    bf16x8 At[4][2], B0[2][2], B1[2][2];
    const char* cA = (const char*)g.A + (size_t)cur.pm * tstep; const char* cB = (const char*)g.Bt + (size_t)cur.pn * tstep;
    S.a_ready(cur);
    if constexpr (SP2) {
        PG8_STAGE(PG8_SB(0, 0), cB, voffB); PG8_STAGE(PG8_SB(0, 1), cB + hstep, voffB); PG8_STAGE(PG8_SA(0, 0), cA, voffA); PG8_STAGE(PG8_SA(0, 1), cA + hstep, voffA);
        if (wr == 1) PG8_BAR;
        PG8_WAIT_V(2); PG8_BAR;
        PG8_STAGE(PG8_SB(1, 0), cB + kstep, voffB); PG8_STAGE(PG8_SB(1, 1), cB + hstep + kstep, voffB);
        PG8_WAIT_V(4); PG8_BAR;
    } else {
        PG8_STAGE(PG8_SB(0, 0), cB, voffB); PG8_STAGE(PG8_SA(0, 0), cA, voffA); PG8_STAGE(PG8_SB(0, 1), cB + hstep, voffB); PG8_STAGE(PG8_SA(0, 1), cA + hstep, voffA);
        if (wr == 1) PG8_BAR;
        PG8_WAIT_V(4); PG8_BAR;
        PG8_STAGE(PG8_SB(1, 0), cB + kstep, voffB); PG8_STAGE(PG8_SA(1, 0), cA + kstep, voffA); PG8_STAGE(PG8_SB(1, 1), cB + hstep + kstep, voffB);
        PG8_WAIT_V(6); PG8_BAR;
    }
    for (;;) {
        const bool has_next = S.next(ui + 1, nxt);
        const char* nA = has_next ? (const char*)g.A + (size_t)nxt.pm * tstep : cA; const char* nB = has_next ? (const char*)g.Bt + (size_t)nxt.pn * tstep : cB;
        for (int t = 0; t < nt; t += 2) {
            const bool last = (t == nt - 2);
            const char* a1 = cA + (size_t)(t + 1) * kstep;
            const char* a2 = last ? nA : cA + (size_t)(t + 2) * kstep; const char* b2 = last ? nB : cB + (size_t)(t + 2) * kstep;
            const char* a3 = a2 + kstep; const char* b3 = b2 + kstep;
            if (last && has_next) S.a_ready(nxt);
            if constexpr (SP2) {
            PG8_LDB(B0, 0, 0); PG8_LDB(B1, 0, 1); PG8_SCHED; PG8_LDA(At, 0, 0); PG8_STAGE(PG8_SA(1, 0), a1, voffA); PG8_STAGE(PG8_SA(1, 1), a1 + hstep, voffA);
            PG8_WAIT_V(8); PG8_WAIT_L(0); PG8_BAR; PG8_MMA(0, 0, At, B0); PG8_MMA(0, 1, At, B1); PG8_BAR; PG8_SCHED;
            PG8_LDA(At, 0, 1); PG8_STAGE(PG8_SB(0, 0), b2, voffB); PG8_STAGE(PG8_SB(0, 1), b2 + hstep, voffB);
            PG8_WAIT_V(6); PG8_WAIT_L(0); PG8_BAR; PG8_MMA(1, 0, At, B0); PG8_MMA(1, 1, At, B1); PG8_BAR; PG8_SCHED;
            PG8_LDB(B0, 1, 0); PG8_LDB(B1, 1, 1); PG8_SCHED; PG8_LDA(At, 1, 0); PG8_STAGE(PG8_SA(0, 0), a2, voffA); PG8_STAGE(PG8_SA(0, 1), a2 + hstep, voffA);
            PG8_WAIT_V(8); PG8_WAIT_L(0); PG8_BAR; PG8_MMA(0, 0, At, B0); PG8_MMA(0, 1, At, B1); PG8_BAR; PG8_SCHED;
            PG8_LDA(At, 1, 1); PG8_STAGE(PG8_SB(1, 0), b3, voffB); PG8_STAGE(PG8_SB(1, 1), b3 + hstep, voffB); (void)a3;
            PG8_WAIT_V(6); PG8_WAIT_L(0); PG8_BAR; PG8_MMA(1, 0, At, B0); PG8_MMA(1, 1, At, B1); PG8_BAR; PG8_SCHED;
            } else {
            PG8_LDB(B0, 0, 0); PG8_SCHED; PG8_LDA(At, 0, 0); PG8_STAGE(PG8_SA(1, 1), a1 + hstep, voffA);
            PG8_WAIT_L(8); PG8_BAR; PG8_WAIT_L(0); PG8_MMA(0, 0, At, B0); PG8_BAR; PG8_SCHED;
            PG8_LDB(B1, 0, 1); PG8_STAGE(PG8_SB(0, 0), b2, voffB);
            PG8_BAR; PG8_WAIT_L(0); PG8_MMA(0, 1, At, B1); PG8_BAR;
            PG8_LDA(At, 0, 1); PG8_STAGE(PG8_SA(0, 0), a2, voffA);
            PG8_BAR; PG8_WAIT_L(0); PG8_MMA(1, 0, At, B0); PG8_BAR; PG8_SCHED;
            PG8_STAGE(PG8_SB(0, 1), b2 + hstep, voffB);
            PG8_WAIT_V(6); PG8_BAR; PG8_MMA(1, 1, At, B1); PG8_BAR;
            PG8_LDB(B0, 1, 0); PG8_SCHED; PG8_LDA(At, 1, 0); PG8_STAGE(PG8_SA(0, 1), a2 + hstep, voffA);
            PG8_WAIT_L(8); PG8_BAR; PG8_WAIT_L(0); PG8_MMA(0, 0, At, B0); PG8_BAR; PG8_SCHED;
            PG8_LDB(B1, 1, 1); PG8_STAGE(PG8_SB(1, 0), b3, voffB);
            PG8_BAR; PG8_WAIT_L(0); PG8_MMA(0, 1, At, B1); PG8_BAR;
            PG8_LDA(At, 1, 1); PG8_STAGE(PG8_SA(1, 0), a3, voffA);
            PG8_BAR; PG8_WAIT_L(0); PG8_MMA(1, 0, At, B0); PG8_BAR; PG8_SCHED;
            PG8_STAGE(PG8_SB(1, 1), b3 + hstep, voffB);
            PG8_WAIT_V(6); PG8_BAR; PG8_MMA(1, 1, At, B1); PG8_BAR;
            }
        }
        if constexpr (ALIGN_EPI) { if (wr == 0) PG8_BAR; }
        if constexpr (!Epi::AFTER_DRAIN) { E(acc, cur, wr, wc, fr, fq); S.done(cur); }
        if (!has_next) break;
#pragma unroll
        for (int a = 0; a < 2; ++a)
#pragma unroll
            for (int b = 0; b < 2; ++b)
#pragma unroll
                for (int m = 0; m < 4; ++m)
#pragma unroll
                    for (int n = 0; n < 2; ++n) acc[a][b][m][n] = (f32x4){0.f, 0.f, 0.f, 0.f};
        cur = nxt; cA = nA; cB = nB; ++ui;
        if constexpr (ALIGN_EPI) { if (wr == 1) PG8_BAR; }
    }
    PG8_WAIT_V(0);
    if constexpr (!ALIGN_EPI) { if (wr == 0) PG8_BAR; }
    PG8_BAR;
    if constexpr (Epi::AFTER_DRAIN) { E.fused(acc, cur, wr, wc, fr, fq, lds, wid, lane); S.done(cur); }
#undef PG8_SA
#undef PG8_SB
#undef PG8_STAGE
#undef PG8_LDA
#undef PG8_LDB
#undef PG8_MMA
#undef PG8_WAIT_V
#undef PG8_WAIT_L
#undef PG8_BAR
#undef PG8_SCHED
}
}

constexpr int SEQ = 16384, DM = 2048, DFF = 8192, DEPTH = 4;
constexpr int QKLD = 4096;
constexpr int VTLD = SEQ;
constexpr float RMS_EPS = 1e-6f;
constexpr float LOG2E = 1.4426950408889634f;
constexpr int ONE_LAUNCH = MK_ONE_LAUNCH;
#ifndef REP_ATTA
#define REP_ATTA 1
#endif
#ifndef REP_ATTB
#define REP_ATTB 1
#endif
#ifndef REP_DMA
#define REP_DMA 1
#endif
#ifndef REP_UP
#define REP_UP 1
#endif
#ifndef REP_P0
#define REP_P0 1
#endif

constexpr size_t MiB = 1u << 20;
constexpr size_t WS_BAR = 0, BAR_BYTES = 32768;
constexpr size_t WS_TAB = 1 * MiB;
constexpr size_t WS_NORMG = 2 * MiB, WS_BLAM = 2 * MiB + 256 * 1024, WS_BSUB = 2 * MiB + 384 * 1024;
constexpr size_t WS_RS = 3 * MiB;
constexpr size_t WS_W = 16 * MiB, W_LAYER = 96 * MiB;
constexpr size_t W_QKV = 0, W_O = 24 * MiB, W_UP = 32 * MiB, W_DOWN = 64 * MiB;
constexpr size_t WS_XN = 400 * MiB;
constexpr size_t WS_QK = 464 * MiB;
constexpr size_t WS_VT = 592 * MiB;
constexpr size_t WS_O = 656 * MiB;
constexpr size_t WS_U = 400 * MiB;
constexpr size_t WS_Y = 720 * MiB;
constexpr size_t WS_HB = 784 * MiB;
constexpr size_t WS_END = 848 * MiB;

constexpr int LDS_RING = 131072, TAB_OFF = 131072, XBST_OFF = 131072 + 1024, LDS_BYTES = 131072 + 1024 + 32;

#define LAS __attribute__((address_space(3)))
typedef unsigned short bf16;
typedef unsigned v4u __attribute__((ext_vector_type(4)));
typedef unsigned v2u __attribute__((ext_vector_type(2)));
typedef float f32x4 __attribute__((ext_vector_type(4)));
typedef short bf16x8 __attribute__((ext_vector_type(8)));
#define LDS_WAIT() asm volatile("s_waitcnt lgkmcnt(0)" ::: "memory")
__device__ __forceinline__ unsigned f2bf(float f) { unsigned u = __builtin_bit_cast(unsigned, f); return (u + 0x7fffu + ((u >> 16) & 1u)) >> 16; }
__device__ __forceinline__ unsigned pk2(float lo, float hi) { return f2bf(lo) | (f2bf(hi) << 16); }
__device__ __forceinline__ float bf_lo(unsigned u) { return __builtin_bit_cast(float, u << 16); }
__device__ __forceinline__ float bf_hi(unsigned u) { return __builtin_bit_cast(float, u & 0xffff0000u); }

namespace att {
__device__ __forceinline__ bf16x8 lds_rd(unsigned addr, const int off) { bf16x8 r; asm volatile("ds_read_b128 %0, %1 offset:%2" : "=v"(r) : "v"(addr), "i"(off) : "memory"); return r; }
__device__ __forceinline__ float xmax16(float x) { float a = x, b = x; asm volatile("s_nop 1\n\tv_permlane16_swap_b32 %0, %1\n\ts_nop 1" : "+v"(a), "+v"(b)); return fmaxf(a, b); }
__device__ __forceinline__ float xmax32(float x) { float a = x, b = x; asm volatile("s_nop 1\n\tv_permlane32_swap_b32 %0, %1\n\ts_nop 1" : "+v"(a), "+v"(b)); return fmaxf(a, b); }
template <int N> __device__ __forceinline__ void lgkm_pin(bf16x8& f) { (void)f; asm volatile("s_waitcnt lgkmcnt(%0)" :: "n"(N) : "memory"); }
template <int DV, int NMAP>
__device__ __forceinline__ void attn_unit(LAS unsigned char* lds, const bf16* __restrict__ QK, const bf16* __restrict__ VT, bf16* __restrict__ O,
                                          const int q0, const int hk0, const int vrow0, const int T0, const int T1, const bool band,
                                          const float* __restrict__ tabg, const float lam, const float outscale, const float* __restrict__ subg) {
    constexpr int STAGE = NMAP * 16384 + DV * 128, NPW = STAGE / 1024 / 8;
    static_assert(NPW == 4 || NPW == 8, "stage pieces per wave");
    int tid_ = threadIdx.x; asm volatile("" : "+v"(tid_));
    const int tid = tid_, wid = __builtin_amdgcn_readfirstlane(tid >> 6), lane = tid & 63, fr = lane & 15, fq = lane >> 4;
    const int qg = (NMAP == 2) ? (wid & 3) : wid, mp = (NMAP == 2) ? (wid >> 2) : 0;
    const int q0w = q0 + 32 * qg, cw = q0w >> 6, qoff = q0w & 63;
    const int lo_w = band ? (cw - 8 > 0 ? cw - 8 : 0) : 0;
    if (tid < 256) ((LAS float*)(lds + TAB_OFF))[tid] = (tid < 255) ? tabg[tid] : 0.f;
    bf16x8 q[2][4];
#pragma unroll
    for (int qb = 0; qb < 2; ++qb)
#pragma unroll
        for (int ks = 0; ks < 4; ++ks) q[qb][ks] = *(const bf16x8*)(QK + (size_t)(q0w + 16 * qb + fr) * QKLD + (hk0 + mp) * 128 + 32 * ks + 8 * fq);
    const int sbb = lane * 16, swz = sbb ^ (((sbb >> 9) & 1) << 5), rr = swz >> 6, cc = (swz & 63) >> 1;
    unsigned vbase; const char* gbase; size_t tstep; const bool isk = wid < 4;
    if (isk) { const int s = wid * NPW, mm = s >> 4, rem = s & 15, ch = rem >> 3, stt = rem & 7, R = 16 * (stt >> 1) + rr;
        const int key = (R & ~31) + pg8::perm32(R & 31), d = 64 * ch + 32 * (stt & 1) + cc;
        vbase = (unsigned)((key * QKLD + 2048 + (hk0 + mm) * 128 + d) * 2); gbase = (const char*)QK; tstep = (size_t)64 * QKLD * 2;
    } else { const int s = (wid - 4) * NPW, dv = 16 * (s >> 1) + rr, key = 32 * (s & 1) + cc;
        vbase = (unsigned)(((vrow0 + dv) * VTLD + key) * 2); gbase = (const char*)VT; tstep = (size_t)64 * 2; }
#define ATT_CJ(j_) (isk ? (size_t)(((32 * ((j_) >> 2) + 4 * (((j_) >> 1) & 1)) * QKLD + 32 * ((j_) & 1)) * 2) : (size_t)((16 * ((j_) >> 1) * VTLD + 32 * ((j_) & 1)) * 2))
#define ATT_STAGE(t_, buf_) do { const char* gb_ = gbase + (size_t)(t_) * tstep; _Pragma("unroll") for (int j_ = 0; j_ < NPW * REP_DMA; ++j_) \
        __builtin_amdgcn_global_load_lds((const unsigned*)(gb_ + ATT_CJ(j_ % NPW) + vbase), (LAS unsigned*)(lds + (buf_) * STAGE + (wid * NPW + j_ % NPW) * 1024), 16, 0, 0); } while (0)
    const int loff = (fr * 64 + fq * 16) ^ (((fr >> 3) & 1) << 5);
    f32x4 o[DV / 16][2];
#pragma unroll
    for (int db = 0; db < DV / 16; ++db) { o[db][0] = (f32x4){0.f, 0.f, 0.f, 0.f}; o[db][1] = (f32x4){0.f, 0.f, 0.f, 0.f}; }
    float lsum[2] = {0.f, 0.f};
    const LAS float* tab = (const LAS float*)(lds + TAB_OFF);
    asm volatile("s_waitcnt vmcnt(0)" ::: "memory");
    ATT_STAGE(T0, 0);
    if ((wid >> 2) ^ (wid & 1)) __builtin_amdgcn_s_setprio(2);
    for (int t = T0; t <= T1; ++t) {
        const int cur = (t - T0) & 1;
        asm volatile("s_waitcnt vmcnt(0)" ::: "memory");
        asm volatile("s_waitcnt lgkmcnt(0)" ::: "memory"); __builtin_amdgcn_s_barrier(); asm volatile("" ::: "memory");
        const bool inr = (t >= lo_w && t <= cw);
        if (t < T1 && (isk || !inr)) ATT_STAGE(t + 1, cur ^ 1);
        if (inr) {
            const LAS unsigned char* st = lds + cur * STAGE;
            f32x4 s[4][2];
#pragma unroll
            for (int kb = 0; kb < 4; ++kb) { s[kb][0] = (f32x4){0.f, 0.f, 0.f, 0.f}; s[kb][1] = (f32x4){0.f, 0.f, 0.f, 0.f}; }
            const unsigned stk = (unsigned)(size_t)(st + mp * 16384 + loff), stv = (unsigned)(size_t)(st + NMAP * 16384 + loff);
#define ATT_KLD(i_) lds_rd(stk, (((i_) >> 2) >> 1) * 8192 + (((i_) & 3) * 2 + (((i_) >> 2) & 1)) * 1024)
#define ATT_VLD(i_) lds_rd(stv, ((((i_) % (DV / 16)) * 2) + ((i_) / (DV / 16))) * 1024)
            { bf16x8 f0 = ATT_KLD(0), f1 = ATT_KLD(1), f2 = ATT_KLD(2);
#pragma unroll
              for (int i = 0; i < 16; ++i) {
                  bf16x8 cur = f0; f0 = f1; f1 = f2; if (i + 3 < 16) f2 = ATT_KLD(i + 3);
                  if (i + 3 < 16) lgkm_pin<3>(cur); else if (i + 2 < 16) lgkm_pin<2>(cur); else if (i + 1 < 16) lgkm_pin<1>(cur); else lgkm_pin<0>(cur);
                  __builtin_amdgcn_sched_barrier(0);
                  s[i & 3][0] = __builtin_amdgcn_mfma_f32_16x16x32_bf16(cur, q[0][i >> 2], s[i & 3][0], 0, 0, 0);
                  s[i & 3][1] = __builtin_amdgcn_mfma_f32_16x16x32_bf16(cur, q[1][i >> 2], s[i & 3][1], 0, 0, 0);
                  __builtin_amdgcn_sched_barrier(0);
              } }
            if (t < T1 && !isk) ATT_STAGE(t + 1, cur ^ 1);
            bf16x8 v0 = ATT_VLD(0), v1 = ATT_VLD(1), v2 = ATT_VLD(2);
            __builtin_amdgcn_sched_barrier(0);
            if (t >= cw - 2) {
                const int tb = 64 * (t - cw + 2) + 8 * fq + 63 - qoff - fr;
#pragma unroll
                for (int kb = 0; kb < 4; ++kb)
#pragma unroll
                    for (int qb = 0; qb < 2; ++qb)
#pragma unroll
                        for (int i = 0; i < 4; ++i) s[kb][qb][i] += tab[tb + 32 * (kb >> 1) + 4 * (kb & 1) + i - 16 * qb];
            }
            bf16x8 pf[2][2];
#pragma unroll
            for (int qb = 0; qb < 2; ++qb) {
#pragma unroll
                for (int kb = 0; kb < 2; ++kb)
#pragma unroll
                    for (int i = 0; i < 4; ++i) s[kb][qb][i] = __builtin_amdgcn_exp2f(s[kb][qb][i]);
                v4u w; w.x = pg8::cvt_pk_bf16(s[0][qb][0], s[0][qb][1]); w.y = pg8::cvt_pk_bf16(s[0][qb][2], s[0][qb][3]);
                w.z = pg8::cvt_pk_bf16(s[1][qb][0], s[1][qb][1]); w.w = pg8::cvt_pk_bf16(s[1][qb][2], s[1][qb][3]); pf[qb][0] = __builtin_bit_cast(bf16x8, w);
                pf[qb][1] = pf[qb][0];
            }
            __builtin_amdgcn_sched_barrier(0);
#pragma unroll
            for (int i = 0; i < 2 * (DV / 16); ++i) {
                constexpr int NV = 2 * (DV / 16), EPS = 16 / (NV / 2);
                if (i == NV / 2) {
#pragma unroll
                    for (int qb = 0; qb < 2; ++qb) {
                        v4u w; w.x = pg8::cvt_pk_bf16(s[2][qb][0], s[2][qb][1]); w.y = pg8::cvt_pk_bf16(s[2][qb][2], s[2][qb][3]);
                        w.z = pg8::cvt_pk_bf16(s[3][qb][0], s[3][qb][1]); w.w = pg8::cvt_pk_bf16(s[3][qb][2], s[3][qb][3]); pf[qb][1] = __builtin_bit_cast(bf16x8, w);
                        const f32x4 pa = (s[0][qb] + s[1][qb]) + (s[2][qb] + s[3][qb]);
                        lsum[qb] += (pa[0] + pa[1]) + (pa[2] + pa[3]);
                    }
                }
                bf16x8 cur = v0; v0 = v1; v1 = v2; if (i + 3 < NV) v2 = ATT_VLD(i + 3);
                if (i + 3 < NV) lgkm_pin<3>(cur); else if (i + 2 < NV) lgkm_pin<2>(cur); else if (i + 1 < NV) lgkm_pin<1>(cur); else lgkm_pin<0>(cur);
                __builtin_amdgcn_sched_barrier(0);
                o[i % (DV / 16)][0] = __builtin_amdgcn_mfma_f32_16x16x32_bf16(cur, pf[0][i / (DV / 16)], o[i % (DV / 16)][0], 0, 0, 0);
                o[i % (DV / 16)][1] = __builtin_amdgcn_mfma_f32_16x16x32_bf16(cur, pf[1][i / (DV / 16)], o[i % (DV / 16)][1], 0, 0, 0);
                if (i < NV / 2) {
#pragma unroll
                    for (int r_ = 0; r_ < EPS; ++r_) { const int e_ = i * EPS + r_; s[2 + (e_ >> 3)][(e_ >> 2) & 1][e_ & 3] = __builtin_amdgcn_exp2f(s[2 + (e_ >> 3)][(e_ >> 2) & 1][e_ & 3]); }
                }
                __builtin_amdgcn_sched_barrier(0);
            }
#undef ATT_KLD
#undef ATT_VLD
        }
    }
    __builtin_amdgcn_s_setprio(0);
    asm volatile("s_waitcnt lgkmcnt(0)" ::: "memory"); __builtin_amdgcn_s_barrier(); asm volatile("" ::: "memory");
#undef ATT_STAGE
#undef ATT_CJ
    float inv[2];
#pragma unroll
    for (int qb = 0; qb < 2; ++qb) { float l = lsum[qb]; l += __shfl_xor(l, 16); l += __shfl_xor(l, 32); inv[qb] = 1.0f / l; }
    if (NMAP == 1) {
#pragma unroll
        for (int qb = 0; qb < 2; ++qb) { bf16* rowp = O + (size_t)(q0w + 16 * qb + fr) * DM + vrow0 + 4 * fq;
#pragma unroll
            for (int db = 0; db < DV / 16; ++db) { const f32x4 v = o[db][qb] * inv[qb]; v2u w; w.x = pg8::cvt_pk_bf16(v[0], v[1]); w.y = pg8::cvt_pk_bf16(v[2], v[3]); *(v2u*)(rowp + 16 * db) = w; } }
    } else {
        LAS f32x4* xch = (LAS f32x4*)(lds + qg * 32768);
        if (mp == 1) {
#pragma unroll
            for (int db = 0; db < DV / 16; ++db)
#pragma unroll
                for (int qb = 0; qb < 2; ++qb) xch[(db * 2 + qb) * 64 + lane] = o[db][qb] * (inv[qb] * lam);
        }
        asm volatile("s_waitcnt lgkmcnt(0)" ::: "memory"); __builtin_amdgcn_s_barrier(); asm volatile("" ::: "memory");
        if (mp == 0) {
            float ss[2] = {0.f, 0.f};
#pragma unroll
            for (int db = 0; db < DV / 16; ++db)
#pragma unroll
                for (int qb = 0; qb < 2; ++qb) { const f32x4 x = o[db][qb] * inv[qb] - xch[(db * 2 + qb) * 64 + lane]; o[db][qb] = x; ss[qb] += (x[0] * x[0] + x[1] * x[1]) + (x[2] * x[2] + x[3] * x[3]); if (qb == 1 && (db & 1)) asm volatile("" ::: "memory"); }
#pragma unroll
            for (int qb = 0; qb < 2; ++qb) { float v = ss[qb]; v += __shfl_xor(v, 16); v += __shfl_xor(v, 32); ss[qb] = outscale / sqrtf(v * (1.0f / DV) + RMS_EPS); }
#pragma unroll
            for (int db = 0; db < DV / 16; ++db) { const f32x4 g = *(const f32x4*)(subg + 16 * db + 4 * fq);
#pragma unroll
                for (int qb = 0; qb < 2; ++qb) { const f32x4 v = o[db][qb] * g * ss[qb]; v2u w; w.x = pg8::cvt_pk_bf16(v[0], v[1]); w.y = pg8::cvt_pk_bf16(v[2], v[3]);
                    *(v2u*)(O + (size_t)(q0w + 16 * qb + fr) * DM + vrow0 + 16 * db + 4 * fq) = w; } }
        }
        asm volatile("s_waitcnt lgkmcnt(0)" ::: "memory"); __builtin_amdgcn_s_barrier(); asm volatile("" ::: "memory");
    }
}
}

#define GAS __attribute__((address_space(1)))
__device__ __forceinline__ float wave_sum(float v) {
#pragma unroll
    for (int o = 1; o < 64; o <<= 1) v += __shfl_xor(v, o);
    return v;
}
__device__ __forceinline__ void p0_transpose_item(const float* W, int K, int N, bf16* WT, int row_off, LAS float* scr, int item, int lane) {
    const int nblk = N / 32, kb = item / nblk, nb = item % nblk, k0 = 64 * kb, n0 = 32 * nb;
#pragma unroll 8
    for (int i = 0; i < 32; ++i) { const int kk = 2 * i + (lane >> 5); scr[kk * 33 + (lane & 31)] = W[(size_t)(k0 + kk) * N + n0 + (lane & 31)]; }
    LDS_WAIT(); asm volatile("" ::: "memory");
    const int c = lane & 7;
#pragma unroll
    for (int j = 0; j < 4; ++j) { const int n = (lane >> 3) + 8 * j; const LAS float* s = scr + (8 * c) * 33 + n;
        v4u o; o.x = pk2(s[0 * 33], s[1 * 33]); o.y = pk2(s[2 * 33], s[3 * 33]); o.z = pk2(s[4 * 33], s[5 * 33]); o.w = pk2(s[6 * 33], s[7 * 33]);
        *(GAS v4u*)(WT + (size_t)(row_off + n0 + n) * K + k0 + 8 * c) = o; }
    LDS_WAIT(); asm volatile("" ::: "memory");
}
__device__ __forceinline__ void p0_transpose_item_g(const float* W, int K, int N, bf16* WT, LAS float* scr, int item, int lane, const float* gk) {
    const int nblk = N / 32, kb = item / nblk, nb = item % nblk, k0 = 64 * kb, n0 = 32 * nb;
    const int c = lane & 7;
    f32x4 g0 = {1.f, 1.f, 1.f, 1.f}, g1 = g0;
    if (gk) { g0 = *(const f32x4*)(gk + k0 + 8 * c); g1 = *(const f32x4*)(gk + k0 + 8 * c + 4); }
#pragma unroll 8
    for (int i = 0; i < 32; ++i) { const int kk = 2 * i + (lane >> 5); scr[kk * 33 + (lane & 31)] = W[(size_t)(k0 + kk) * N + n0 + (lane & 31)]; }
    LDS_WAIT(); asm volatile("" ::: "memory");
#pragma unroll
    for (int j = 0; j < 4; ++j) { const int n = (lane >> 3) + 8 * j; const LAS float* sp = scr + (8 * c) * 33 + n;
        v4u o; o.x = pk2(sp[0 * 33] * g0[0], sp[1 * 33] * g0[1]); o.y = pk2(sp[2 * 33] * g0[2], sp[3 * 33] * g0[3]); o.z = pk2(sp[4 * 33] * g1[0], sp[5 * 33] * g1[1]); o.w = pk2(sp[6 * 33] * g1[2], sp[7 * 33] * g1[3]);
        *(GAS v4u*)(WT + (size_t)(n0 + n) * K + k0 + 8 * c) = o; }
    LDS_WAIT(); asm volatile("" ::: "memory");
}
__device__ __forceinline__ int t5_bucket(int rel) {
    const int ret = rel > 0 ? 16 : 0, n = rel < 0 ? -rel : rel;
    if (n < 8) return ret + n;
    int large = 8 + (31 - __builtin_clz((unsigned)(n * n))) - 6;
    if (large > 15) large = 15;
    return ret + large;
}
template <bool HIN_BF16, bool HOUT_BF16>
__device__ __forceinline__ void norm_rows(const bf16* __restrict__ Y, const void* Hin, void* H, const float* __restrict__ gpost, float* __restrict__ RSout, int gw, int NGW, int lane) {
    const bool blk_ = (NGW == 2048); const int m0_ = blk_ ? 2048 * ((gw >> 3) & 7) + 64 * (gw >> 6) + 8 * (gw & 7) : gw, ms_ = blk_ ? 1 : NGW, me_ = blk_ ? m0_ + 8 : SEQ;
    for (int m = m0_; m < me_; m += ms_) {
        f32x4 h[8];
        if (HIN_BF16) {
#pragma unroll
            for (int j = 0; j < 4; ++j) { const v4u w = *(const v4u*)((const bf16*)Hin + (size_t)m * DM + 512 * j + 8 * lane);
                h[2 * j] = (f32x4){bf_lo(w[0]), bf_hi(w[0]), bf_lo(w[1]), bf_hi(w[1])}; h[2 * j + 1] = (f32x4){bf_lo(w[2]), bf_hi(w[2]), bf_lo(w[3]), bf_hi(w[3])}; }
        } else {
            const float* hr = (const float*)Hin + (size_t)m * DM + 8 * lane;
#pragma unroll
            for (int j = 0; j < 4; ++j) { h[2 * j] = *(const f32x4*)(hr + 512 * j); h[2 * j + 1] = *(const f32x4*)(hr + 512 * j + 4); }
        }
        if (Y) {
            v4u y[4]; float ss = 0.f;
#pragma unroll
            for (int j = 0; j < 4; ++j) y[j] = *(const v4u*)(Y + (size_t)m * DM + 512 * j + 8 * lane);
#pragma unroll
            for (int j = 0; j < 4; ++j)
#pragma unroll
                for (int e = 0; e < 4; ++e) { const float a = bf_lo(y[j][e]), b = bf_hi(y[j][e]); ss += a * a + b * b; }
            const float rs = 1.0f / sqrtf(wave_sum(ss) * (1.0f / DM) + RMS_EPS);
#pragma unroll
            for (int j = 0; j < 4; ++j) { const f32x4 g0 = *(const f32x4*)(gpost + 512 * j + 8 * lane), g1 = *(const f32x4*)(gpost + 512 * j + 8 * lane + 4);
                f32x4 a = {bf_lo(y[j][0]), bf_hi(y[j][0]), bf_lo(y[j][1]), bf_hi(y[j][1])}, b = {bf_lo(y[j][2]), bf_hi(y[j][2]), bf_lo(y[j][3]), bf_hi(y[j][3])};
                h[2 * j] = h[2 * j] + a * g0 * rs; h[2 * j + 1] = h[2 * j + 1] + b * g1 * rs; }
        }
        if (HOUT_BF16) {
#pragma unroll
            for (int j = 0; j < 4; ++j) { v4u w; w.x = pk2(h[2 * j][0], h[2 * j][1]); w.y = pk2(h[2 * j][2], h[2 * j][3]); w.z = pk2(h[2 * j + 1][0], h[2 * j + 1][1]); w.w = pk2(h[2 * j + 1][2], h[2 * j + 1][3]);
                *(v4u*)((bf16*)H + (size_t)m * DM + 512 * j + 8 * lane) = w; }
        } else { float* ho = (float*)H + (size_t)m * DM + 8 * lane;
#pragma unroll
            for (int j = 0; j < 4; ++j) { *(f32x4*)(ho + 512 * j) = h[2 * j]; *(f32x4*)(ho + 512 * j + 4) = h[2 * j + 1]; } }
        if (RSout) {
            float ss = 0.f;
#pragma unroll
            for (int j = 0; j < 8; ++j) ss += (h[j][0] * h[j][0] + h[j][1] * h[j][1]) + (h[j][2] * h[j][2] + h[j][3] * h[j][3]);
            const float rs = 1.0f / sqrtf(wave_sum(ss) * (1.0f / DM) + RMS_EPS);
            if (lane == 0) RSout[m] = rs;
        }
    }
}

#define XB_TMO      128
#define XB_XCNT(j)  (256  + 64 * (j))
#define XB_XSUB(j)  (1280 + 64 * (j))
#define XB_XGEN(j)  (2304 + 64 * (j))
#define XB_TOP      3328
#define XB_TOPGEN   3392
#define XCD_BAR_WORDS 3456
#define XB_SPIN_CAP (1u << 18)

__device__ __forceinline__ unsigned xb_ld(unsigned* p)              { return __hip_atomic_load(p, __ATOMIC_RELAXED, __HIP_MEMORY_SCOPE_AGENT); }
__device__ __forceinline__ unsigned xb_add(unsigned* p, unsigned v) { return __hip_atomic_fetch_add(p, v, __ATOMIC_RELAXED, __HIP_MEMORY_SCOPE_AGENT); }
__device__ __forceinline__ unsigned xb_xcc_id() { return (unsigned)__builtin_amdgcn_s_getreg((3 << 11) | 20) & 0xFu; }
#define XB_SPIN(cond, bar) do { unsigned _sp = 0; while (cond) { __builtin_amdgcn_s_sleep(1); \
    if ((++_sp & 255u) == 0u) { if (xb_ld(&(bar)[XB_TMO])) break; if (_sp > XB_SPIN_CAP) { atomicAdd(&(bar)[XB_TMO], 1u); break; } } } } while (0)

struct XcdBarrier {
    unsigned* bar; unsigned x;
    volatile LAS unsigned* st;
};

__device__ __forceinline__ XcdBarrier xcd_barrier_post(unsigned* bar, volatile LAS unsigned* st) {
    XcdBarrier b; b.bar = bar; b.x = xb_xcc_id(); b.st = st;
    if (threadIdx.x == 0) (void)xb_add(&bar[XB_XCNT(b.x)], 1u);
    return b;
}
__device__ __forceinline__ void xcd_barrier_complete(unsigned* bar, unsigned x, unsigned& nloc, unsigned& nx) {
    const unsigned G = gridDim.x * gridDim.y * gridDim.z;
    unsigned sum, cnt, mine, sp = 0u;
    for (;;) {
        sum = 0u; cnt = 0u; mine = 0u;
#pragma unroll
        for (unsigned j = 0; j < 16; ++j) { const unsigned c = xb_ld(&bar[XB_XCNT(j)]); sum += c; cnt += (c > 0u) ? 1u : 0u; mine = (j == x) ? c : mine; }
        if (sum == G) break;
        __builtin_amdgcn_s_sleep(1);
        if ((++sp & 255u) == 0u) { if (xb_ld(&bar[XB_TMO])) break; if (sp > XB_SPIN_CAP) { atomicAdd(&bar[XB_TMO], 1u); break; } }
    }
    nloc = mine > 0u ? mine : 1u; nx = cnt > 0u ? cnt : 1u;
}

__device__ __forceinline__ void xcd_barrier(const XcdBarrier& b) {
    asm volatile("s_waitcnt vmcnt(0)" ::: "memory");
    __syncthreads();
    if (threadIdx.x == 0) {
        unsigned* bar = b.bar;
        __builtin_amdgcn_s_waitcnt(0);
        unsigned nloc = b.st[0], nx = b.st[1];
        if (nloc == 0u) { xcd_barrier_complete(bar, b.x, nloc, nx); b.st[0] = nloc; b.st[1] = nx; }
        const unsigned old = xb_add(&bar[XB_XSUB(b.x)], 1u);
        const unsigned gen = old / nloc;
        if (old + 1u == (gen + 1u) * nloc) {
            __builtin_amdgcn_fence(__ATOMIC_RELEASE, "agent");
            asm volatile("s_waitcnt vmcnt(0)" ::: "memory");
            const unsigned og = xb_add(&bar[XB_TOP], 1u);
            const unsigned tg = og / nx;
            if (og + 1u == (tg + 1u) * nx) xb_add(&bar[XB_TOPGEN], 1u);
            else XB_SPIN(xb_ld(&bar[XB_TOPGEN]) == tg, bar);
            __builtin_amdgcn_fence(__ATOMIC_ACQUIRE, "agent");
            xb_add(&bar[XB_XGEN(b.x)], 1u);
            asm volatile("s_waitcnt vmcnt(0)" ::: "memory");
        } else {
            XB_SPIN(xb_ld(&bar[XB_XGEN(b.x)]) == gen, bar);
            __builtin_amdgcn_fence(__ATOMIC_ACQUIRE, "agent");
            asm volatile("s_waitcnt vmcnt(0)" ::: "memory");
        }
    }
    __syncthreads();
}
#define XB_LSUB(j) (4096 + 64 * (j))
#define XB_LGEN(j) (5120 + 64 * (j))
#define XB_MISMATCH 6144
__device__ __forceinline__ void xcd_local_barrier(const XcdBarrier& b) {
    asm volatile("s_waitcnt vmcnt(0)" ::: "memory");
    __syncthreads();
    if (threadIdx.x == 0) {
        unsigned* bar = b.bar;
        __builtin_amdgcn_s_waitcnt(0);
        const unsigned nloc = b.st[0];
        const unsigned old = xb_add(&bar[XB_LSUB(b.x)], 1u), gen = old / nloc;
        if (old + 1u == (gen + 1u) * nloc) xb_add(&bar[XB_LGEN(b.x)], 1u);
        else XB_SPIN(xb_ld(&bar[XB_LGEN(b.x)]) == gen, bar);
        __builtin_amdgcn_fence(__ATOMIC_ACQUIRE, "agent");
        asm volatile("s_waitcnt vmcnt(0)" ::: "memory");
    }
    __syncthreads();
}
struct Args { const float* in[12]; float* out; unsigned char* ws; float lam_init[2]; int ph_lo, ph_hi; };
static_assert(sizeof(Args) == 128, "Args has no padding");
enum { IN_X = 0, IN_NORMG, IN_AQKV, IN_AO, IN_ABIAS, IN_BQKV, IN_BO, IN_BLAM, IN_BSUB, IN_T5, IN_UP, IN_DOWN };

__global__ void __launch_bounds__(512, 2) trunk_fwd(Args a) {
    extern __shared__ __attribute__((aligned(16))) unsigned char lds_raw[];
    LAS unsigned char* lds = (LAS unsigned char*)lds_raw;
    cg::grid_group grid = cg::this_grid();
    const int wave = __builtin_amdgcn_readfirstlane((int)threadIdx.x >> 6);
    const int G = gridDim.x, bx = blockIdx.x;
#define FRESH_TID() int tid = threadIdx.x; asm volatile("" : "+v"(tid)); const int lane = tid & 63
    int vb = bx;
    const int NGW = G * 8;
#define gw (vb * 8 + wave)
#define FRESH_WS() unsigned long long wz_ = 0; asm volatile("" : "+s"(wz_)); unsigned char* ws = a.ws + wz_; bf16* XN = (bf16*)(ws + WS_XN); bf16* QK = (bf16*)(ws + WS_QK); bf16* VT = (bf16*)(ws + WS_VT); bf16* OB = (bf16*)(ws + WS_O); \
    bf16* UB = (bf16*)(ws + WS_U); bf16* YB = (bf16*)(ws + WS_Y); float* TAB = (float*)(ws + WS_TAB); const float* normg = (const float*)(ws + WS_NORMG); \
    (void)XN; (void)QK; (void)VT; (void)OB; (void)UB; (void)YB; (void)TAB; (void)normg
    if (threadIdx.x < 8) ((LAS unsigned*)(lds + XBST_OFF))[threadIdx.x] = 0u;
    __syncthreads();
    XcdBarrier xbar; xbar.bar = (unsigned*)(a.ws + WS_BAR); xbar.x = 0; xbar.st = (volatile LAS unsigned*)(lds + XBST_OFF);
    int ph = 0;
#define RUN() (a.ph_lo <= ph && ph < a.ph_hi)
#ifndef REP_SYNC
#define REP_SYNC 1
#endif
#define XB_RANK(j) (6400 + 64 * (j))
#define XST ((volatile LAS unsigned*)(lds + XBST_OFF))
#define SEAM() do { if (a.ph_lo <= ph && ph + 1 < a.ph_hi) { \
        if (ph == 0) { grid.sync(); xbar = xcd_barrier_post((unsigned*)(a.ws + WS_BAR), XST); \
            if (threadIdx.x == 0) XST[5] = xb_add(&xbar.bar[XB_RANK(xbar.x & 7u)], 1u);                        \
            xcd_barrier(xbar);                                                                                \
            if (threadIdx.x == 0 && !(XST[0] == 32u && XST[1] == 8u && xbar.x < 8u && XST[5] < 32u && G == 256)) (void)xb_add(&xbar.bar[XB_MISMATCH], 1u); \
            xcd_barrier(xbar); \
            if (threadIdx.x == 0) XST[4] = (xb_ld(&xbar.bar[XB_MISMATCH]) == 0u) ? 1u : 2u; \
            __syncthreads(); \
            if (XST[4] == 1u) vb = __builtin_amdgcn_readfirstlane((int)(XST[5] * 8u + xbar.x)); } \
        else { const int k_ = (ph - 1) % 7; const bool loc_ = (k_ >= 2 && k_ <= 5) && XST[4] == 1u; \
            if (loc_) xcd_local_barrier(xbar); else xcd_barrier(xbar); } } ++ph; } while (0)

    if (RUN()) {
        FRESH_TID(); FRESH_WS();
        if (bx == 0) for (int e = tid; e < (int)(BAR_BYTES / 4); e += 512) ((unsigned*)(ws + WS_BAR))[e] = 0u;
        LAS float* scr = (LAS float*)(lds + wave * 16384);
        constexpr int I_QKV = (DM / 64) * (3 * DM / 32), I_O = (DM / 64) * (DM / 32), I_UP = (DM / 64) * (DFF / 32), I_DN = (DFF / 64) * (DM / 32), I_LAYER = I_QKV + I_O + I_UP + I_DN;
        for (int rep = 0; rep < REP_P0; ++rep)
        for (int it = gw; it < DEPTH * I_LAYER; it += NGW) {
            const int L = it / I_LAYER; int r = it % I_LAYER; const int i = L >> 1;
            bf16* wl = (bf16*)(ws + WS_W + (size_t)L * W_LAYER);
            if (r < I_QKV) { p0_transpose_item_g(((L & 1) ? a.in[IN_BQKV] : a.in[IN_AQKV]) + (size_t)i * DM * 3 * DM, DM, 3 * DM, wl + W_QKV / 2, scr, r, lane, a.in[IN_NORMG] + (size_t)(L * 4 + 0) * DM); continue; } r -= I_QKV;
            if (r < I_O) { p0_transpose_item_g(((L & 1) ? a.in[IN_BO] : a.in[IN_AO]) + (size_t)i * DM * DM, DM, DM, wl + W_O / 2, scr, r, lane, nullptr); continue; } r -= I_O;
            if (r < I_UP) { p0_transpose_item_g(a.in[IN_UP] + (size_t)L * DM * DFF, DM, DFF, wl + W_UP / 2, scr, r, lane, a.in[IN_NORMG] + (size_t)(L * 4 + 2) * DM); continue; } r -= I_UP;
            p0_transpose_item_g(a.in[IN_DOWN] + (size_t)L * DFF * DM, DFF, DM, wl + W_DOWN / 2, scr, r, lane, nullptr);
        }
        for (int e = bx * 512 + tid; e < (2 * 16 + 8) * 256; e += G * 512) {
            const int idx = e & 255, hh = e >> 8, rel = idx - 191; float v = 0.f;
            if (idx < 255) {
                if (hh < 32) { const int i = hh >> 4, h = hh & 15; const float* rb = a.in[IN_ABIAS] + (size_t)i * 257 * 16; int c = rel < -128 ? -128 : (rel > 128 ? 128 : rel);
                    v = (rb[(c + 128) * 16 + h] - rb[h]) * LOG2E; }
                else { const int h = hh - 32; const float* t5 = a.in[IN_T5]; v = (t5[t5_bucket(rel) * 8 + h] - t5[15 * 8 + h]) * LOG2E; }
            }
            TAB[e] = v;
        }
        for (int e = bx * 512 + tid; e < DEPTH * 4 * DM; e += G * 512) ((float*)(ws + WS_NORMG))[e] = a.in[IN_NORMG][e];
        for (int e = bx * 512 + tid; e < 2 * 4 * 128; e += G * 512) ((float*)(ws + WS_BLAM))[e] = a.in[IN_BLAM][e];
        for (int e = bx * 512 + tid; e < 2 * 256; e += G * 512) ((float*)(ws + WS_BSUB))[e] = a.in[IN_BSUB][e];
        norm_rows<false, true>(nullptr, a.in[IN_X], ws + WS_HB, nullptr, (float*)(ws + WS_RS), gw, NGW, lane);
    }
    SEAM();

    for (int L = 0; L < DEPTH; ++L) {
        if (RUN()) {
            FRESH_WS(); const bf16* wl = (const bf16*)(ws + WS_W + (size_t)L * W_LAYER);
            { pg8::Gemm g{(const bf16*)(ws + WS_HB), wl + W_QKV / 2, SEQ, 2 * DM, DM}; pg8::StaticOrder S; S.init(SEQ, 2 * DM, G, vb);
              pg8::EpiBf16<0> E{QK, QKLD, DM, 0.08838834764831845f * LOG2E, (const float*)(ws + WS_RS), 1};
              pg8::gemm_phase<pg8::EpiBf16<0>, pg8::StaticOrder, true, true>(lds, g, S, E); }
            { pg8::Gemm g{wl + W_QKV / 2 + (size_t)2 * DM * DM, (const bf16*)(ws + WS_HB), DM, SEQ, DM}; pg8::StaticOrder S; S.init(DM, SEQ, G, vb);
              pg8::EpiBf16<0> E{VT, VTLD, 0, 1.f, (const float*)(ws + WS_RS), 2};
              pg8::gemm_phase<pg8::EpiBf16<0>, pg8::StaticOrder, true, true>(lds, g, S, E); }
        }
        SEAM();
        if (RUN()) {
            FRESH_WS(); int u0 = vb; asm volatile("" : "+s"(u0));
            if ((L & 1) == 0) {
                const float* tabA = TAB + (size_t)(L >> 1) * 16 * 256;
                for (int rep = 0; rep < REP_ATTA; ++rep)
                for (int u = u0; u < 64 * 16; u += G) {
                    const int h = u & 15, qblk = u >> 4, c0 = 4 * qblk;
#ifndef NO_ATTA
                    att::attn_unit<128, 1>(lds, QK, VT, OB, 256 * qblk, h, 128 * h, (c0 - 8 > 0 ? c0 - 8 : 0), c0 + 3, true, tabA + h * 256, 0.f, 1.f, nullptr);
#endif
                }
            } else {
                FRESH_TID(); (void)tid;
                const int i = L >> 1;
                const float* lf = (const float*)(ws + WS_BLAM) + (size_t)i * 4 * 128;
                const float s1 = wave_sum(lf[lane] * lf[128 + lane] + lf[64 + lane] * lf[192 + lane]), s2 = wave_sum(lf[256 + lane] * lf[384 + lane] + lf[320 + lane] * lf[448 + lane]);
                const float li = a.lam_init[i], lam = expf(s1) - expf(s2) + li;
                const float* tabB = TAB + (size_t)32 * 256;
                for (int rep = 0; rep < REP_ATTB; ++rep)
                for (int u = u0; u < 128 * 8; u += G) {
                    const int h = u & 7, j = u >> 3, ii = j & 31, r = j >> 5;
                    const int qblk = (r == 0) ? 127 - ii : (r == 1) ? 64 + ii : (r == 2) ? 63 - ii : ii;
#ifndef NO_ATTB
                    att::attn_unit<256, 2>(lds, QK, VT, OB, 128 * qblk, 2 * h, 256 * h, 0, 2 * qblk + 1, false, tabB + h * 256, lam, 1.0f - li, (const float*)(ws + WS_BSUB) + (size_t)i * 256);
#endif
                }
            }
        }
        SEAM();
        if (RUN()) {
            FRESH_WS(); const bf16* wl = (const bf16*)(ws + WS_W + (size_t)L * W_LAYER);
            pg8::Gemm g{OB, wl + W_O / 2, SEQ, DM, DM}; pg8::StaticOrder S; S.init(SEQ, DM, G, vb);
            pg8::EpiBf16<0> E{YB, DM, 0, 1.f, nullptr, 0};
            pg8::gemm_phase<pg8::EpiBf16<0>, pg8::StaticOrder, true, true>(lds, g, S, E);
        }
        SEAM();
        if (RUN()) { FRESH_TID(); (void)tid; FRESH_WS(); const float* gL = normg + (size_t)L * 4 * DM; norm_rows<true, true>(YB, ws + WS_HB, ws + WS_HB, gL + DM, (float*)(ws + WS_RS), gw, NGW, lane); }
        SEAM();
        if (RUN()) {
            FRESH_WS(); const bf16* wl = (const bf16*)(ws + WS_W + (size_t)L * W_LAYER);
            for (int rep = 0; rep < REP_UP; ++rep) {
            pg8::Gemm g{(const bf16*)(ws + WS_HB), wl + W_UP / 2, SEQ, DFF, DM}; pg8::StaticOrder S; S.init(SEQ, DFF, G, vb);
            pg8::EpiBf16<2> E{UB, DFF, 0, 1.f, (const float*)(ws + WS_RS), 1};
            pg8::gemm_phase<pg8::EpiBf16<2>, pg8::StaticOrder, true, true>(lds, g, S, E);
            }
        }
        SEAM();
        if (RUN()) {
            FRESH_WS(); const bf16* wl = (const bf16*)(ws + WS_W + (size_t)L * W_LAYER);
            pg8::Gemm g{UB, wl + W_DOWN / 2, SEQ, DM, DFF}; pg8::StaticOrder S; S.init(SEQ, DM, G, vb);
            pg8::EpiBf16<0> E{YB, DM, 0, 1.f, nullptr, 0};
            pg8::gemm_phase<pg8::EpiBf16<0>, pg8::StaticOrder, true, true>(lds, g, S, E);
        }
        SEAM();
        if (RUN()) { FRESH_TID(); (void)tid; FRESH_WS(); const float* gL = normg + (size_t)L * 4 * DM; if (L + 1 < DEPTH) norm_rows<true, true>(YB, ws + WS_HB, ws + WS_HB, gL + 3 * DM, (float*)(ws + WS_RS), gw, NGW, lane);
            else norm_rows<true, false>(YB, ws + WS_HB, a.out, gL + 3 * DM, nullptr, gw, NGW, lane); }
        SEAM();
    }
#undef RUN
#undef SEAM
}
constexpr int N_PHASES = 1 + 7 * DEPTH;

extern "C" void kernel_launch(void* const* d_in, const int* in_sizes, int n_in, void* d_out, int out_size, void* d_ws, size_t ws_size, hipStream_t stream) {
    static int grid = 0;
    if (grid == 0) {
        if (n_in != 12 || in_sizes[0] != SEQ * DM || out_size != SEQ * DM || ws_size < WS_END) { fprintf(stderr, "kernel_launch: unexpected shapes (n_in %d, ws %zu); nothing launched\n", n_in, ws_size); grid = -1; return; }
        int dev = 0, cus = 0, per_cu = 0;
        if (hipGetDevice(&dev) != hipSuccess || hipDeviceGetAttribute(&cus, hipDeviceAttributeMultiprocessorCount, dev) != hipSuccess) { grid = -1; return; }
        if (hipFuncSetAttribute((const void*)trunk_fwd, hipFuncAttributeMaxDynamicSharedMemorySize, LDS_BYTES) != hipSuccess) { fprintf(stderr, "kernel_launch: hipFuncSetAttribute failed\n"); grid = -1; return; }
        if (hipOccupancyMaxActiveBlocksPerMultiprocessor(&per_cu, (const void*)trunk_fwd, 512, LDS_BYTES) != hipSuccess || per_cu < 1) { fprintf(stderr, "kernel_launch: occupancy query says %d blocks per CU\n", per_cu); per_cu = 1; }
        (void)hipGetLastError();
        grid = cus;
    }
    if (grid < 0) return;
    Args a{};
    for (int i = 0; i < 12; ++i) a.in[i] = (const float*)d_in[i];
    a.out = (float*)d_out; a.ws = (unsigned char*)d_ws;
    a.lam_init[0] = (float)(0.8 - 0.6 * exp(-0.3 * 1.0)); a.lam_init[1] = (float)(0.8 - 0.6 * exp(-0.3 * 3.0));
    if (ONE_LAUNCH) {
        a.ph_lo = 0; a.ph_hi = N_PHASES;
        void* args[] = {&a};
        hipError_t e = hipLaunchCooperativeKernel((const void*)trunk_fwd, dim3(grid), dim3(512), args, LDS_BYTES, stream);
        if (e != hipSuccess) fprintf(stderr, "kernel_launch: cooperative launch failed: %s (grid %d)\n", hipGetErrorString(e), grid);
    } else {
        for (int p = 0; p < N_PHASES; ++p) { a.ph_lo = p; a.ph_hi = p + 1; hipLaunchKernelGGL(trunk_fwd, dim3(grid), dim3(512), LDS_BYTES, stream, a); }
    }
}
```
